# Optimizing an MI355X kernel written in HIP

```python
import math
import jax, jax.numpy as jnp
from jax import lax
import numpy as np

D_MODEL = 1024
BATCH = 2
SEQ = 8192
DEPTH = 1

POOL_WINDOWS = (2, 4, 8, 16)
POOL_WIDTH = D_MODEL // 2
POOL_GROUP = POOL_WIDTH // len(POOL_WINDOWS)
HEAD_DIM = 64
ATTN_GROUPS = ((128, 1), (512, 4), (2048, 16))
HEADS_PER_GROUP = 4
N_HEADS = HEADS_PER_GROUP * len(ATTN_GROUPS)
ATTN_WIDTH = N_HEADS * HEAD_DIM
ATTN_OUT_WIDTH = HEADS_PER_GROUP * HEAD_DIM
ATTN_BLOCK = 128
ROT_DIM = HEAD_DIM // 4
ROPE_THETA = 500000.0
N_BRANCHES = 2
IN_WIDTH = POOL_WIDTH + 3 * ATTN_WIDTH + N_BRANCHES * D_MODEL
N_EXPERTS = 32
TOP_K = 4
D_EXPERT = D_MODEL
SWIGLU_ALPHA = 1.702
SWIGLU_LIMIT = 7.0
MOE_BLOCK = 256
DN_ALPHA = (2.0 * DEPTH) ** 0.25
DN_BETA = (8.0 * DEPTH) ** -0.25
LN_EPS = 1e-5
NEG_INF = -1e30

kernel_name = "hybrid_pool_dilated_attn_moe_deepnorm_adaln"


def layer_norm(x, g=None, b=None):
    xf = x.astype(jnp.float32)
    mu = jnp.mean(xf, axis=-1, keepdims=True)
    var = jnp.mean(jnp.square(xf - mu), axis=-1, keepdims=True)
    y = (xf - mu) * lax.rsqrt(var + LN_EPS)
    if g is not None:
        y = y * g.astype(jnp.float32) + b.astype(jnp.float32)
    return y.astype(x.dtype)


def pool_mixer(xp, pool_w, pool_scale):
    B, S, _ = xp.shape
    G = len(POOL_WINDOWS)
    xf = xp.reshape(B, S, G, POOL_GROUP).astype(jnp.float32)
    cs = jnp.cumsum(xf, axis=1)
    cs0 = jnp.concatenate([jnp.zeros_like(cs[:, :1]), cs], axis=1)
    t = jnp.arange(S)
    means = []
    for g, w in enumerate(POOL_WINDOWS):
        c_g = cs0[:, :, g]
        lo = jnp.concatenate([jnp.zeros((B, w - 1, POOL_GROUP), jnp.float32),
                              c_g[:, :S - w + 1]], axis=1)
        cnt = jnp.minimum(t + 1, w).astype(jnp.float32)[None, :, None]
        means.append((c_g[:, 1:] - lo) / cnt)
    mixed = (jnp.stack(means, axis=2) - xf).astype(xp.dtype)
    y = jnp.einsum('bsgc,gcd->bsgd', mixed, pool_w).reshape(B, S, POOL_WIDTH)
    return y * pool_scale


def partial_rotary(x, positions):
    half = ROT_DIM // 2
    inv_freq = jnp.power(ROPE_THETA, -jnp.arange(half, dtype=jnp.float32) * (2.0 / ROT_DIM))
    ang = positions.astype(jnp.float32)[..., None] * inv_freq
    cos = jnp.cos(ang)[:, :, None, :]
    sin = jnp.sin(ang)[:, :, None, :]
    xf = x.astype(jnp.float32)
    x1, x2 = xf[..., :half], xf[..., half:ROT_DIM]
    out = jnp.concatenate([x1 * cos - x2 * sin, x2 * cos + x1 * sin, xf[..., ROT_DIM:]], axis=-1)
    return out.astype(x.dtype)


def dilated_window_attention(q, k, v, window, dilation):
    B, S, H, E = q.shape
    n_back = window // dilation
    L = S // dilation
    nb = -(-L // ATTN_BLOCK)
    Lp = nb * ATTN_BLOCK

    def to_blocks(a):
        a = a.reshape(B, L, dilation, H, E).transpose(0, 2, 1, 3, 4)
        a = jnp.pad(a, ((0, 0), (0, 0), (0, Lp - L), (0, 0), (0, 0)))
        return a.reshape(B, dilation, nb, ATTN_BLOCK, H, E)

    def with_prev(a):
        prev = jnp.pad(a[:, :, :-1], ((0, 0), (0, 0), (1, 0), (0, 0), (0, 0), (0, 0)))
        return jnp.concatenate([prev, a], axis=3)

    qb = to_blocks(q)
    kk = with_prev(to_blocks(k))
    vv = with_prev(to_blocks(v))
    s = jnp.einsum('bdnqhe,bdnkhe->bdnhqk', qb, kk,
                   preferred_element_type=jnp.float32) * (E ** -0.5)
    qi = jnp.arange(ATTN_BLOCK)[:, None]
    kj = jnp.arange(2 * ATTN_BLOCK)[None, :]
    dist = ATTN_BLOCK + qi - kj
    band = (dist >= 0) & (dist <= n_back)
    has_prev = (jnp.arange(nb)[:, None, None] > 0) | (kj[None] >= ATTN_BLOCK)
    mask = band[None] & has_prev
    s = jnp.where(mask[None, None, :, None], s, NEG_INF)
    m = jnp.max(s, axis=-1, keepdims=True)
    p = jnp.exp(s - m)
    den = jnp.sum(p, axis=-1, keepdims=True)
    o = jnp.einsum('bdnhqk,bdnkhe->bdnqhe', p.astype(v.dtype), vv,
                   preferred_element_type=jnp.float32)
    o = o / jnp.swapaxes(den, 3, 4)
    lse = jnp.swapaxes((m + jnp.log(den))[..., 0], 3, 4)
    o = o.reshape(B, dilation, Lp, H, E)[:, :, :L].transpose(0, 2, 1, 3, 4).reshape(B, S, H, E)
    lse = lse.reshape(B, dilation, Lp, H)[:, :, :L].transpose(0, 2, 1, 3).reshape(B, S, H)
    return o, lse


def clamped_swiglu_expert(xb, wg, bg, wu, bu, wd, bd):
    g = xb @ wg + bg
    up = xb @ wu + bu
    g = jnp.minimum(g, SWIGLU_LIMIT)
    up = jnp.clip(up, -SWIGLU_LIMIT, SWIGLU_LIMIT)
    h = g * jax.nn.sigmoid(SWIGLU_ALPHA * g) * (up + 1.0)
    return h @ wd + bd


def moe_ffn(u, w_router, b_router, w_gate, b_gate, w_up, b_up, w_down, b_down):
    B, S, D = u.shape
    N = B * S
    A = N * TOP_K
    xt = u.reshape(N, D)
    logits = (xt @ w_router).astype(jnp.float32) + b_router.astype(jnp.float32)
    top_val, top_idx = lax.top_k(logits, TOP_K)
    probs = jax.nn.softmax(top_val, axis=-1)
    eid = top_idx.reshape(A).astype(jnp.int32)
    tid = jnp.arange(A, dtype=jnp.int32) // TOP_K
    wgt = probs.reshape(A)
    order = jnp.argsort(eid)
    se = eid[order]
    counts = jax.ops.segment_sum(jnp.ones((A,), jnp.int32), eid, num_segments=N_EXPERTS)
    offsets = jnp.cumsum(counts) - counts
    padded = (counts + MOE_BLOCK - 1) // MOE_BLOCK * MOE_BLOCK
    pad_ends = jnp.cumsum(padded)
    pad_offsets = pad_ends - padded
    dest = pad_offsets[se] + jnp.arange(A, dtype=jnp.int32) - offsets[se]
    nblk = -(-A // MOE_BLOCK) + N_EXPERTS
    P = nblk * MOE_BLOCK
    row_tok = jnp.full((P,), N, jnp.int32).at[dest].set(tid[order])
    row_w = jnp.zeros((P,), jnp.float32).at[dest].set(wgt[order])
    blk_exp = jnp.minimum(jnp.searchsorted(pad_ends, jnp.arange(nblk) * MOE_BLOCK, side='right'),
                          N_EXPERTS - 1).astype(jnp.int32)
    xpad = jnp.concatenate([xt, jnp.zeros((1, D), xt.dtype)], axis=0)
    xs = xpad[row_tok].reshape(nblk, MOE_BLOCK, D)

    def expert_block(args):
        xb, e = args
        return clamped_swiglu_expert(xb, w_gate[e], b_gate[e], w_up[e], b_up[e], w_down[e], b_down[e])

    ys = lax.map(expert_block, (xs, blk_exp)).reshape(P, D)
    out = jax.ops.segment_sum(ys.astype(jnp.float32) * row_w[:, None], row_tok,
                              num_segments=N + 1)[:N]
    return out.astype(u.dtype).reshape(B, S, D)


def setup_inputs(seed: int = 0) -> dict:
    key = jax.random.key(seed)
    ks = jax.random.split(key, 26)
    nrm = lambda k, shape, s: jax.random.normal(k, shape, jnp.float32) * s
    Dd, L = D_MODEL, DEPTH
    G = len(POOL_WINDOWS)
    x = jax.random.normal(ks[0], (BATCH, SEQ, Dd), jnp.float32)
    c = jax.random.normal(ks[1], (BATCH, Dd), jnp.float32)
    offs = jax.random.randint(ks[2], (BATCH, 1), 0, 4096, jnp.int32)
    positions = (jnp.arange(SEQ, dtype=jnp.int32)[None, :] + offs).astype(jnp.int32)
    return {
        "x": x,
        "c": c,
        "positions": positions,
        "w_ada": nrm(ks[3], (L, Dd, 6 * Dd), 0.1 * Dd ** -0.5),
        "b_ada": nrm(ks[4], (L, 6 * Dd), 0.01),
        "w_in": nrm(ks[5], (L, Dd, IN_WIDTH), Dd ** -0.5),
        "pool_w": nrm(ks[6], (L, G, POOL_GROUP, POOL_GROUP), POOL_GROUP ** -0.5),
        "pool_scale": 1.0 + nrm(ks[7], (L, POOL_WIDTH), 0.1),
        "w_pool_out": nrm(ks[8], (L, POOL_WIDTH, Dd), POOL_WIDTH ** -0.5),
        "w_attn_out": nrm(ks[9], (L, ATTN_OUT_WIDTH, Dd), ATTN_OUT_WIDTH ** -0.5),
        "w_o": nrm(ks[10], (L, Dd, Dd), DN_BETA * Dd ** -0.5),
        "ln1_g": 1.0 + nrm(ks[11], (L, Dd), 0.02),
        "ln1_b": nrm(ks[12], (L, Dd), 0.02),
        "w_router": nrm(ks[13], (L, Dd, N_EXPERTS), Dd ** -0.5),
        "b_router": nrm(ks[14], (L, N_EXPERTS), 0.01),
        "w_gate": nrm(ks[15], (L, N_EXPERTS, Dd, D_EXPERT), Dd ** -0.5),
        "b_gate": nrm(ks[16], (L, N_EXPERTS, D_EXPERT), 0.01),
        "w_up": nrm(ks[17], (L, N_EXPERTS, Dd, D_EXPERT), Dd ** -0.5),
        "b_up": nrm(ks[18], (L, N_EXPERTS, D_EXPERT), 0.01),
        "w_down": nrm(ks[19], (L, N_EXPERTS, D_EXPERT, Dd), DN_BETA * D_EXPERT ** -0.5),
        "b_down": nrm(ks[20], (L, N_EXPERTS, Dd), 0.01),
        "ln2_g": 1.0 + nrm(ks[21], (L, Dd), 0.02),
        "ln2_b": nrm(ks[22], (L, Dd), 0.02),
    }


def reference(x, c, positions, w_ada, b_ada, w_in, pool_w, pool_scale, w_pool_out, w_attn_out,
              w_o, ln1_g, ln1_b, w_router, b_router, w_gate, b_gate, w_up, b_up, w_down, b_down,
              ln2_g, ln2_b):
    B, S, D = x.shape
    splits = [POOL_WIDTH, POOL_WIDTH + ATTN_WIDTH, POOL_WIDTH + 2 * ATTN_WIDTH,
              POOL_WIDTH + 3 * ATTN_WIDTH, POOL_WIDTH + 3 * ATTN_WIDTH + D_MODEL]
    for l in range(DEPTH):
        ada = jax.nn.silu(c) @ w_ada[l] + b_ada[l]
        shift1, scale1, gate1, shift2, scale2, gate2 = jnp.split(ada[:, None, :], 6, axis=-1)

        u = layer_norm(x) * (1.0 + scale1) + shift1
        proj = u @ w_in[l]
        xp, q, k, v, g_p, g_a = jnp.split(proj, splits, axis=-1)

        pool_y = pool_mixer(xp, pool_w[l], pool_scale[l])

        q = partial_rotary(q.reshape(B, S, N_HEADS, HEAD_DIM), positions)
        k = partial_rotary(k.reshape(B, S, N_HEADS, HEAD_DIM), positions)
        v = v.reshape(B, S, N_HEADS, HEAD_DIM)
        outs, lses = [], []
        for gi, (window, dilation) in enumerate(ATTN_GROUPS):
            hs = slice(gi * HEADS_PER_GROUP, (gi + 1) * HEADS_PER_GROUP)
            o, lse = dilated_window_attention(q[:, :, hs], k[:, :, hs], v[:, :, hs], window, dilation)
            outs.append(o)
            lses.append(lse)
        mix_w = jax.nn.softmax(jnp.stack(lses, axis=0), axis=0)
        attn = jnp.sum(mix_w[..., None] * jnp.stack(outs, axis=0), axis=0)
        attn = attn.reshape(B, S, ATTN_OUT_WIDTH).astype(x.dtype)

        merged = (jax.nn.sigmoid(g_p) * (pool_y @ w_pool_out[l])
                  + jax.nn.sigmoid(g_a) * (attn @ w_attn_out[l]))
        mix = merged @ w_o[l]
        x = layer_norm(DN_ALPHA * x + (1.0 + gate1) * mix, ln1_g[l], ln1_b[l])

        u2 = layer_norm(x) * (1.0 + scale2) + shift2
        ffn = moe_ffn(u2, w_router[l], b_router[l], w_gate[l], b_gate[l], w_up[l], b_up[l],
                      w_down[l], b_down[l])
        x = layer_norm(DN_ALPHA * x + (1.0 + gate2) * ffn, ln2_g[l], ln2_b[l])
    return x
```

```cpp
#include <hip/hip_runtime.h>
#include <stdint.h>
#include <stdio.h>

typedef unsigned short bf16_t;
typedef unsigned u32x4 __attribute__((ext_vector_type(4)));

constexpr int NB = 2, S = 8192, D = 1024, NTOK = NB * S;
constexpr int POOLW = 512, PGRP = 128;
constexpr int HD = 64, NH = 12, AW = 768, AOW = 256;
constexpr int INW = POOLW + 3 * AW + 2 * D;
constexpr int NE = 32, TOPK = 4, NASSIGN = NTOK * TOPK;
constexpr int MAXTILES = 288, PMAX = MAXTILES * 256;
constexpr float LN_EPS = 1e-5f;
constexpr float DN_ALPHA = 1.189207115002721f;
constexpr float SW_ALPHA = 1.702f, SW_LIMIT = 7.0f;

constexpr size_t MiB = 1u << 20;
constexpr size_t WS_CTL = 0, CTL_BYTES = 1 * MiB;
constexpr size_t WS_ADA = 1 * MiB;
constexpr size_t WS_ROPE = 2 * MiB;
constexpr size_t WS_TOKE = 3 * MiB;
constexpr size_t WS_TOKW = WS_TOKE + 256 * 1024;
constexpr size_t WS_TOKP = WS_TOKW + 256 * 1024;
constexpr size_t WS_META = WS_TOKP + 256 * 1024;
constexpr size_t WS_LIST = 4 * MiB;
constexpr size_t WS_WIN = 8 * MiB;
constexpr size_t WS_WPOOL = 18 * MiB;
constexpr size_t WS_WCAT = 19 * MiB;
constexpr size_t WS_WO = 21 * MiB;
constexpr size_t WS_WDN = 24 * MiB;
constexpr size_t WS_WGU = 88 * MiB;
constexpr size_t WS_YB = 88 * MiB;
constexpr size_t WS_U = 216 * MiB;
constexpr size_t WS_XP = 248 * MiB;
constexpr size_t WS_Q = 264 * MiB, WS_K = 288 * MiB, WS_V = 312 * MiB;
constexpr size_t WS_GP = 336 * MiB, WS_GA = 368 * MiB;
constexpr size_t WS_H = 248 * MiB;
constexpr size_t WS_ACAT = 400 * MiB;
constexpr size_t WS_LSE = 424 * MiB;
constexpr size_t WS_OG = 426 * MiB;
constexpr size_t WS_MIX = 450 * MiB;
constexpr size_t WS_END = 470 * MiB;
constexpr int CW_CNT = 1024;

__device__ __forceinline__ float bf2f(bf16_t v) { return __uint_as_float((unsigned)v << 16); }
__device__ __forceinline__ bf16_t f2bf(float f) { unsigned u = __float_as_uint(f); return (bf16_t)((u + 0x7fffu + ((u >> 16) & 1u)) >> 16); }
__device__ __forceinline__ float sigmoidf_(float x) { return 1.0f / (1.0f + __expf(-x)); }
__device__ __forceinline__ float wave_sum(float v) {
#pragma unroll
    for (int o = 1; o < 64; o <<= 1) v += __shfl_xor(v, o);
    return v;
}

__device__ __forceinline__ int rowmap(int n, int mode) { return mode == 0 ? n : (256 * (n >> 7) + (n & 127) + (mode == 2 ? 128 : 0)); }
__global__ void __launch_bounds__(256) k_transpose(const float* src, int K, int N, size_t sbatch, bf16_t* dst, int dld, int koff, size_t dbatch, int mode) {
    __shared__ float t[32][33];
    src += (size_t)blockIdx.z * sbatch; dst += (size_t)blockIdx.z * dbatch;
    const int n0 = blockIdx.x * 32, k0 = blockIdx.y * 32, tx = threadIdx.x & 31, ty = threadIdx.x >> 5;
    for (int i = ty; i < 32; i += 8) t[i][tx] = src[(size_t)(k0 + i) * N + n0 + tx];
    __syncthreads();
    for (int i = ty; i < 32; i += 8) dst[(size_t)rowmap(n0 + i, mode) * dld + koff + k0 + tx] = f2bf(t[tx][i]);
}
__global__ void __launch_bounds__(256) k_ada(const float* c, const float* w_ada, const float* b_ada, float* ada) {
    const int j = blockIdx.x * 256 + threadIdx.x, b = blockIdx.y;
    float acc = b_ada[j];
    for (int k = 0; k < D; ++k) { const float cv = c[b * D + k]; acc += (cv * sigmoidf_(cv)) * w_ada[(size_t)k * (6 * D) + j]; }
    ada[b * 6 * D + j] = acc;
}
__constant__ float c_invfreq[8] = {1.0f, 0.1939227432012558f, 0.03760603070259094f, 0.007292664609849453f, 0.0014142135623842478f, 0.00027424818836152554f, 5.318296098266728e-05f, 1.0313386155758053e-05f};
__global__ void __launch_bounds__(256) k_rope(const int* positions, float* rope) {
    const int i = blockIdx.x * 256 + threadIdx.x; if (i >= NTOK * 8) return;
    const int tok = i >> 3, f = i & 7;
    const float ang = (float)positions[tok] * c_invfreq[f];
    rope[tok * 16 + f] = cosf(ang); rope[tok * 16 + 8 + f] = sinf(ang);
}
__global__ void __launch_bounds__(256) k_ln_mod(const float* x, const float* ada, int shift_idx, int scale_idx, bf16_t* U) {
    const int row = blockIdx.x * 4 + (threadIdx.x >> 6), lane = threadIdx.x & 63, b = row / S;
    const float* xr = x + (size_t)row * D;
    float v[16]; float s = 0.f;
#pragma unroll
    for (int j = 0; j < 16; ++j) { v[j] = xr[lane + 64 * j]; s += v[j]; }
    const float mean = wave_sum(s) * (1.f / D); float q = 0.f;
#pragma unroll
    for (int j = 0; j < 16; ++j) { v[j] -= mean; q += v[j] * v[j]; }
    const float rstd = rsqrtf(wave_sum(q) * (1.f / D) + LN_EPS);
    const float* sh = ada + b * 6 * D + shift_idx * D; const float* sc = ada + b * 6 * D + scale_idx * D;
#pragma unroll
    for (int j = 0; j < 16; ++j) { const int c = lane + 64 * j; U[(size_t)row * D + c] = f2bf(v[j] * rstd * (1.f + sc[c]) + sh[c]); }
}

template <class Epi, bool DUAL, int KSPLIT>
__global__ void __launch_bounds__(256) k_gemm_naive(const bf16_t* A, int lda, const bf16_t* Bt, int ldb, int K, Epi epi) {
    __shared__ float As[64][33], Bs[64][33], Bs2[DUAL ? 64 : 1][33];
    const int row0 = blockIdx.y * 64, col0 = blockIdx.x * 64, tid = threadIdx.x, tx = tid & 15, ty = tid >> 4;
    if (!epi.tile_ok(row0)) return;
    const bf16_t* Bb = Bt + epi.b_off(row0);
    const int lr = tid >> 2, lk = (tid & 3) * 8;
    const bf16_t* ap = A + (size_t)epi.a_row(row0 + lr) * lda + lk;
    const bf16_t* bp = Bb + (size_t)epi.b_row(col0 + lr) * ldb + lk;
    float acc[4][4], acc2[4][4];
#pragma unroll
    for (int i = 0; i < 4; ++i)
#pragma unroll
        for (int j = 0; j < 4; ++j) { acc[i][j] = 0.f; acc2[i][j] = 0.f; }
    for (int k0 = 0; k0 < K; k0 += 32) {
        if (KSPLIT > 0 && k0 == KSPLIT) {
#pragma unroll
            for (int i = 0; i < 4; ++i)
#pragma unroll
                for (int j = 0; j < 4; ++j) epi.mid(row0 + ty * 4 + i, col0 + tx * 4 + j, acc[i][j]);
        }
        const u32x4 av = *(const u32x4*)(ap + k0), bv = *(const u32x4*)(bp + k0);
        u32x4 bv2 = {0, 0, 0, 0}; if (DUAL) bv2 = *(const u32x4*)(bp + (size_t)128 * ldb + k0);
        __syncthreads();
#pragma unroll
        for (int j = 0; j < 4; ++j) {
            As[lr][lk + 2 * j] = __uint_as_float(av[j] << 16); As[lr][lk + 2 * j + 1] = __uint_as_float(av[j] & 0xffff0000u);
            Bs[lr][lk + 2 * j] = __uint_as_float(bv[j] << 16); Bs[lr][lk + 2 * j + 1] = __uint_as_float(bv[j] & 0xffff0000u);
            if (DUAL) { Bs2[lr][lk + 2 * j] = __uint_as_float(bv2[j] << 16); Bs2[lr][lk + 2 * j + 1] = __uint_as_float(bv2[j] & 0xffff0000u); }
        }
        __syncthreads();
#pragma unroll 8
        for (int kk = 0; kk < 32; ++kk) {
            float a[4], b[4], b2[4];
#pragma unroll
            for (int i = 0; i < 4; ++i) { a[i] = As[ty * 4 + i][kk]; b[i] = Bs[tx * 4 + i][kk]; b2[i] = DUAL ? Bs2[tx * 4 + i][kk] : 0.f; }
#pragma unroll
            for (int i = 0; i < 4; ++i)
#pragma unroll
                for (int j = 0; j < 4; ++j) { acc[i][j] += a[i] * b[j]; if (DUAL) acc2[i][j] += a[i] * b2[j]; }
        }
    }
#pragma unroll
    for (int i = 0; i < 4; ++i)
#pragma unroll
        for (int j = 0; j < 4; ++j) epi(row0 + ty * 4 + i, col0 + tx * 4 + j, acc[i][j], acc2[i][j]);
}
struct EpiBase {
    __device__ bool tile_ok(int) const { return true; }
    __device__ size_t b_off(int) const { return 0; }
    __device__ int b_row(int n) const { return n; }
    __device__ int a_row(int m) const { return m; }
    __device__ void mid(int, int, float&) const {}
};
struct EpiProj : EpiBase {
    bf16_t *xp, *q, *k, *v, *gp, *ga;
    __device__ void operator()(int m, int n, float a, float) const {
        const bf16_t o = f2bf(a);
        if (n < 512) { xp[(size_t)m * 512 + n] = o; return; } n -= 512;
        if (n < 768) { q[(size_t)m * 768 + n] = o; return; } n -= 768;
        if (n < 768) { k[(size_t)m * 768 + n] = o; return; } n -= 768;
        if (n < 768) { v[(size_t)m * 768 + n] = o; return; } n -= 768;
        if (n < 1024) { gp[(size_t)m * 1024 + n] = o; return; } n -= 1024;
        ga[(size_t)m * 1024 + n] = o;
    }
};
__global__ void __launch_bounds__(256) k_rotary(bf16_t* qk, const float* rope, float scale) {
    const int i = blockIdx.x * 256 + threadIdx.x; if (i >= NTOK * NH * 8) return;
    const int f = i & 7, h = (i >> 3) % NH, tok = i / (8 * NH);
    bf16_t* p = qk + (size_t)tok * AW + h * HD;
    const float c = rope[tok * 16 + f], s = rope[tok * 16 + 8 + f], x1 = bf2f(p[f]), x2 = bf2f(p[f + 8]);
    p[f] = f2bf((x1 * c - x2 * s) * scale); p[f + 8] = f2bf((x2 * c + x1 * s) * scale);
}
__global__ void __launch_bounds__(256) k_scale_rest(bf16_t* q, float scale) {
    const int i = blockIdx.x * 256 + threadIdx.x; if (i >= NTOK * NH * 48) return;
    const int d = 16 + i % 48, h = (i / 48) % NH, tok = i / (48 * NH);
    bf16_t* p = q + (size_t)tok * AW + h * HD + d; *p = f2bf(bf2f(*p) * scale);
}
__global__ void __launch_bounds__(256) k_pool_mix(const bf16_t* xp, bf16_t* mix) {
    const int i = blockIdx.x * 256 + threadIdx.x; if (i >= NTOK * POOLW) return;
    const int c = i & 511, tok = i >> 9, t = tok % S, g = c >> 7, w = 2 << g;
    const int cnt = (t + 1 < w) ? t + 1 : w; float s = 0.f;
    for (int j = 0; j < cnt; ++j) s += bf2f(xp[(size_t)(tok - j) * POOLW + c]);
    mix[i] = f2bf(s / (float)cnt - bf2f(xp[i]));
}
struct EpiPool : EpiBase {
    bf16_t* acat; const float* pscale; int g;
    __device__ void operator()(int m, int n, float a, float) const { acat[(size_t)m * 768 + 256 + g * 128 + n] = f2bf(a * pscale[g * 128 + n]); }
};
__global__ void __launch_bounds__(256) k_attn_naive(const bf16_t* Q, const bf16_t* Kb, const bf16_t* Vb, bf16_t* OG, float* LSE) {
    const int i = blockIdx.x * 256 + threadIdx.x; if (i >= NTOK * NH) return;
    const int h = i % NH, tok = i / NH, b = tok / S, t = tok % S, g = h >> 2, dl = (g == 0) ? 1 : (g == 1 ? 4 : 16);
    float q[64], o[64];
#pragma unroll
    for (int e = 0; e < 64; ++e) { q[e] = bf2f(Q[(size_t)tok * AW + h * HD + e]); o[e] = 0.f; }
    float m = -1e30f, den = 0.f;
    const int jq = t / dl;
    const int nk = (jq < 128) ? jq + 1 : 129;
    for (int j = 0; j < nk; ++j) {
        const int kt = b * S + t - j * dl;
        const bf16_t* kp = Kb + (size_t)kt * AW + h * HD; const bf16_t* vp = Vb + (size_t)kt * AW + h * HD;
        float s = 0.f;
#pragma unroll
        for (int e = 0; e < 64; ++e) s += q[e] * bf2f(kp[e]);
        const float mn = fmaxf(m, s), a = __expf(m - mn), p = __expf(s - mn);
        den = den * a + p;
#pragma unroll
        for (int e = 0; e < 64; ++e) o[e] = o[e] * a + p * bf2f(vp[e]);
        m = mn;
    }
    const float inv = 1.f / den;
#pragma unroll
    for (int e = 0; e < 64; ++e) OG[(size_t)tok * AW + h * HD + e] = f2bf(o[e] * inv);
    LSE[tok * NH + h] = m + __logf(den);
}
__global__ void __launch_bounds__(256) k_merge(const bf16_t* OG, const float* LSE, bf16_t* acat) {
    const int i = blockIdx.x * 256 + threadIdx.x; if (i >= NTOK * AOW) return;
    const int e = i & 63, hs = (i >> 6) & 3, tok = i >> 8;
    const float l0 = LSE[tok * NH + hs], l1 = LSE[tok * NH + 4 + hs], l2 = LSE[tok * NH + 8 + hs];
    const float mx = fmaxf(l0, fmaxf(l1, l2)), w0 = __expf(l0 - mx), w1 = __expf(l1 - mx), w2 = __expf(l2 - mx), inv = 1.f / (w0 + w1 + w2);
    const float v = (w0 * bf2f(OG[(size_t)tok * AW + hs * HD + e]) + w1 * bf2f(OG[(size_t)tok * AW + (4 + hs) * HD + e]) + w2 * bf2f(OG[(size_t)tok * AW + (8 + hs) * HD + e])) * inv;
    acat[(size_t)tok * 768 + hs * HD + e] = f2bf(v);
}
struct EpiMerged : EpiBase {
    const bf16_t *gp, *ga; bf16_t* out;
    __device__ void mid(int m, int n, float& acc) const {
        const float a = bf2f(ga[(size_t)m * D + n]), p = fmaxf(bf2f(gp[(size_t)m * D + n]), -30.f);
        acc *= sigmoidf_(a) * (1.f + __expf(-p));
    }
    __device__ void operator()(int m, int n, float acc, float) const {
        const float p = fmaxf(bf2f(gp[(size_t)m * D + n]), -30.f);
        out[(size_t)m * D + n] = f2bf(acc * sigmoidf_(p));
    }
};
struct EpiWo : EpiBase {
    const float *x, *ada; float* y;
    __device__ void operator()(int m, int n, float acc, float) const {
        const int b = m / S; y[(size_t)m * D + n] = DN_ALPHA * x[(size_t)m * D + n] + (1.f + ada[b * 6 * D + 2 * D + n]) * acc;
    }
};
__global__ void __launch_bounds__(256) k_ln1_router(float* y, const float* ada, const float* g1, const float* b1, const float* w_router, const float* b_router,
                                                    bf16_t* U2, int* tok_e, float* tok_w, int* tok_p, int* list, int* cnt) {
    const int row = blockIdx.x * 4 + (threadIdx.x >> 6), lane = threadIdx.x & 63, b = row / S;
    float* yr = y + (size_t)row * D;
    float v[16]; float s = 0.f;
#pragma unroll
    for (int j = 0; j < 16; ++j) { v[j] = yr[lane + 64 * j]; s += v[j]; }
    float mean = wave_sum(s) * (1.f / D), q = 0.f;
#pragma unroll
    for (int j = 0; j < 16; ++j) { v[j] -= mean; q += v[j] * v[j]; }
    float rstd = rsqrtf(wave_sum(q) * (1.f / D) + LN_EPS);
    s = 0.f;
#pragma unroll
    for (int j = 0; j < 16; ++j) { const int c = lane + 64 * j; v[j] = v[j] * rstd * g1[c] + b1[c]; yr[c] = v[j]; s += v[j]; }
    mean = wave_sum(s) * (1.f / D); q = 0.f;
#pragma unroll
    for (int j = 0; j < 16; ++j) { v[j] -= mean; q += v[j] * v[j]; }
    rstd = rsqrtf(wave_sum(q) * (1.f / D) + LN_EPS);
    const float* sh = ada + b * 6 * D + 3 * D; const float* sc = ada + b * 6 * D + 4 * D;
#pragma unroll
    for (int j = 0; j < 16; ++j) { const int c = lane + 64 * j; v[j] = v[j] * rstd * (1.f + sc[c]) + sh[c]; U2[(size_t)row * D + c] = f2bf(v[j]); }
    float lg[NE];
#pragma unroll
    for (int e = 0; e < NE; ++e) lg[e] = 0.f;
#pragma unroll
    for (int j = 0; j < 16; ++j) { const float* wr = w_router + (size_t)(lane + 64 * j) * NE;
#pragma unroll
        for (int e = 0; e < NE; ++e) lg[e] += v[j] * wr[e]; }
#pragma unroll
    for (int e = 0; e < NE; ++e) lg[e] = wave_sum(lg[e]) + b_router[e];
    if (lane == 0) {
        int idx[4]; float val[4]; unsigned used = 0u;
#pragma unroll
        for (int k = 0; k < 4; ++k) { int bi = 0; float bv = -3.4e38f;
#pragma unroll
            for (int e = 0; e < NE; ++e) if (!((used >> e) & 1u) && lg[e] > bv) { bv = lg[e]; bi = e; }
            used |= 1u << bi; idx[k] = bi; val[k] = bv; }
        float den = 0.f, p[4];
#pragma unroll
        for (int k = 0; k < 4; ++k) { p[k] = __expf(val[k] - val[0]); den += p[k]; }
#pragma unroll
        for (int k = 0; k < 4; ++k) {
            const int pos = atomicAdd(&cnt[idx[k]], 1);
            tok_e[row * 4 + k] = idx[k]; tok_w[row * 4 + k] = p[k] / den; tok_p[row * 4 + k] = pos;
            list[idx[k] * NTOK + pos] = row * 4 + k;
        }
    }
}
__global__ void k_moe_meta(const int* cnt, int* meta) {
    if (threadIdx.x == 0) { int off = 0, nt = 0;
        for (int e = 0; e < NE; ++e) { meta[e] = off; const int t = (cnt[e] + 255) / 256; for (int i = 0; i < t; ++i) meta[128 + nt + i] = e; nt += t; off += t * 256; }
        meta[32] = off; meta[64] = nt; }
}
struct EpiMoeBase {
    const int *meta, *cnt, *list;
    __device__ bool tile_ok(int row0) const { return (row0 >> 8) < meta[64]; }
    __device__ int expert(int row0) const { return meta[128 + (row0 >> 8)]; }
    __device__ int src(int m) const { const int e = expert(m), pos = m - meta[e]; return pos < cnt[e] ? list[e * NTOK + pos] : -1; }
    __device__ void mid(int, int, float&) const {}
};
struct EpiGU : EpiMoeBase {
    const float *bg, *bu; bf16_t* H;
    __device__ size_t b_off(int row0) const { return (size_t)expert(row0) * 2048 * 1024; }
    __device__ int b_row(int n) const { return 256 * (n >> 7) + (n & 127); }
    __device__ int a_row(int m) const { const int s = src(m); return s < 0 ? 0 : (s >> 2); }
    __device__ void operator()(int m, int n, float g, float u) const {
        const int e = expert(m);
        g += bg[e * 1024 + n]; u += bu[e * 1024 + n];
        g = fminf(g, SW_LIMIT); u = fminf(fmaxf(u, -SW_LIMIT), SW_LIMIT);
        H[(size_t)m * 1024 + n] = f2bf(g * sigmoidf_(SW_ALPHA * g) * (u + 1.f));
    }
};
struct EpiDown : EpiMoeBase {
    const float *bd, *tok_w; bf16_t* YB;
    __device__ size_t b_off(int row0) const { return (size_t)expert(row0) * 1024 * 1024; }
    __device__ int b_row(int n) const { return n; }
    __device__ int a_row(int m) const { return m; }
    __device__ void operator()(int m, int n, float a, float) const {
        const int s = src(m); if (s < 0) return;
        YB[(size_t)s * 1024 + n] = f2bf((a + bd[expert(m) * 1024 + n]) * tok_w[s]);
    }
};
__global__ void __launch_bounds__(256) k_final(float* x1, const bf16_t* YB, const float* ada, const float* g2, const float* b2) {
    const int row = blockIdx.x * 4 + (threadIdx.x >> 6), lane = threadIdx.x & 63, b = row / S;
    float* xr = x1 + (size_t)row * D; const float* gate = ada + b * 6 * D + 5 * D;
    float v[16]; float s = 0.f;
#pragma unroll
    for (int j = 0; j < 16; ++j) { const int c = lane + 64 * j; float f = 0.f;
        for (int k = 0; k < 4; ++k) f += bf2f(YB[((size_t)row * 4 + k) * D + c]);
        v[j] = DN_ALPHA * xr[c] + (1.f + gate[c]) * f; s += v[j]; }
    const float mean = wave_sum(s) * (1.f / D); float q = 0.f;
#pragma unroll
    for (int j = 0; j < 16; ++j) { v[j] -= mean; q += v[j] * v[j]; }
    const float rstd = rsqrtf(wave_sum(q) * (1.f / D) + LN_EPS);
#pragma unroll
    for (int j = 0; j < 16; ++j) { const int c = lane + 64 * j; xr[c] = v[j] * rstd * g2[c] + b2[c]; }
}

extern "C" void kernel_launch(void* const* d_in, const int* in_sizes, int n_in, void* d_out, int out_size, void* d_ws, size_t ws_size, hipStream_t stream) {
    if (ws_size < WS_END) { fprintf(stderr, "workspace too small\n"); return; }
    const float* x = (const float*)d_in[0]; const float* c = (const float*)d_in[1]; const int* positions = (const int*)d_in[2];
    const float* w_ada = (const float*)d_in[3]; const float* b_ada = (const float*)d_in[4]; const float* w_in = (const float*)d_in[5];
    const float* pool_w = (const float*)d_in[6]; const float* pool_scale = (const float*)d_in[7]; const float* w_pool_out = (const float*)d_in[8];
    const float* w_attn_out = (const float*)d_in[9]; const float* w_o = (const float*)d_in[10]; const float* ln1_g = (const float*)d_in[11];
    const float* ln1_b = (const float*)d_in[12]; const float* w_router = (const float*)d_in[13]; const float* b_router = (const float*)d_in[14];
    const float* w_gate = (const float*)d_in[15]; const float* b_gate = (const float*)d_in[16]; const float* w_up = (const float*)d_in[17];
    const float* b_up = (const float*)d_in[18]; const float* w_down = (const float*)d_in[19]; const float* b_down = (const float*)d_in[20];
    const float* ln2_g = (const float*)d_in[21]; const float* ln2_b = (const float*)d_in[22];
    unsigned char* ws = (unsigned char*)d_ws; float* out = (float*)d_out;
    int* ctl = (int*)(ws + WS_CTL); float* ada = (float*)(ws + WS_ADA); float* rope = (float*)(ws + WS_ROPE);
    int* tok_e = (int*)(ws + WS_TOKE); float* tok_w = (float*)(ws + WS_TOKW); int* tok_p = (int*)(ws + WS_TOKP); int* meta = (int*)(ws + WS_META); int* list = (int*)(ws + WS_LIST);
    bf16_t *wt_in = (bf16_t*)(ws + WS_WIN), *wt_pool = (bf16_t*)(ws + WS_WPOOL), *wt_cat = (bf16_t*)(ws + WS_WCAT), *wt_o = (bf16_t*)(ws + WS_WO), *wt_dn = (bf16_t*)(ws + WS_WDN), *wt_gu = (bf16_t*)(ws + WS_WGU);
    bf16_t *YB = (bf16_t*)(ws + WS_YB), *U = (bf16_t*)(ws + WS_U), *XP = (bf16_t*)(ws + WS_XP), *Q = (bf16_t*)(ws + WS_Q), *Kb = (bf16_t*)(ws + WS_K), *Vb = (bf16_t*)(ws + WS_V);
    bf16_t *GP = (bf16_t*)(ws + WS_GP), *GA = (bf16_t*)(ws + WS_GA), *H = (bf16_t*)(ws + WS_H), *ACAT = (bf16_t*)(ws + WS_ACAT), *OG = (bf16_t*)(ws + WS_OG), *MIX = (bf16_t*)(ws + WS_MIX);
    float* LSE = (float*)(ws + WS_LSE);
    int* cnt = ctl + CW_CNT;

    (void)hipMemsetAsync(ws + WS_CTL, 0, CTL_BYTES, stream);
    k_transpose<<<dim3(INW / 32, D / 32, 1), 256, 0, stream>>>(w_in, D, INW, 0, wt_in, D, 0, 0, 0);
    k_transpose<<<dim3(4, 4, 4), 256, 0, stream>>>(pool_w, 128, 128, 128 * 128, wt_pool, 128, 0, 128 * 128, 0);
    k_transpose<<<dim3(D / 32, AOW / 32, 1), 256, 0, stream>>>(w_attn_out, AOW, D, 0, wt_cat, 768, 0, 0, 0);
    k_transpose<<<dim3(D / 32, POOLW / 32, 1), 256, 0, stream>>>(w_pool_out, POOLW, D, 0, wt_cat, 768, 256, 0, 0);
    k_transpose<<<dim3(D / 32, D / 32, 1), 256, 0, stream>>>(w_o, D, D, 0, wt_o, D, 0, 0, 0);
    k_transpose<<<dim3(D / 32, D / 32, NE), 256, 0, stream>>>(w_gate, D, D, (size_t)D * D, wt_gu, D, 0, (size_t)2048 * D, 1);
    k_transpose<<<dim3(D / 32, D / 32, NE), 256, 0, stream>>>(w_up, D, D, (size_t)D * D, wt_gu, D, 0, (size_t)2048 * D, 2);
    k_transpose<<<dim3(D / 32, D / 32, NE), 256, 0, stream>>>(w_down, D, D, (size_t)D * D, wt_dn, D, 0, (size_t)D * D, 0);
    k_ada<<<dim3(6 * D / 256, NB), 256, 0, stream>>>(c, w_ada, b_ada, ada);
    k_rope<<<NTOK * 8 / 256, 256, 0, stream>>>(positions, rope);
    k_ln_mod<<<NTOK / 4, 256, 0, stream>>>(x, ada, 0, 1, U);
    { EpiProj e; e.xp = XP; e.q = Q; e.k = Kb; e.v = Vb; e.gp = GP; e.ga = GA;
      k_gemm_naive<EpiProj, false, 0><<<dim3(INW / 64, NTOK / 64), 256, 0, stream>>>(U, D, wt_in, D, D, e); }
    k_rotary<<<NTOK * NH * 8 / 256, 256, 0, stream>>>(Q, rope, 0.125f);
    k_scale_rest<<<NTOK * NH * 48 / 256, 256, 0, stream>>>(Q, 0.125f);
    k_rotary<<<NTOK * NH * 8 / 256, 256, 0, stream>>>(Kb, rope, 1.0f);
    k_pool_mix<<<NTOK * POOLW / 256, 256, 0, stream>>>(XP, MIX);
    for (int g = 0; g < 4; ++g) { EpiPool e; e.acat = ACAT; e.pscale = pool_scale; e.g = g;
      k_gemm_naive<EpiPool, false, 0><<<dim3(128 / 64, NTOK / 64), 256, 0, stream>>>(MIX + g * 128, POOLW, wt_pool + g * 128 * 128, 128, 128, e); }
    k_attn_naive<<<NTOK * NH / 256, 256, 0, stream>>>(Q, Kb, Vb, OG, LSE);
    k_merge<<<NTOK * AOW / 256, 256, 0, stream>>>(OG, LSE, ACAT);
    { EpiMerged e; e.gp = GP; e.ga = GA; e.out = U;
      k_gemm_naive<EpiMerged, false, 256><<<dim3(D / 64, NTOK / 64), 256, 0, stream>>>(ACAT, 768, wt_cat, 768, 768, e); }
    { EpiWo e; e.x = x; e.ada = ada; e.y = out;
      k_gemm_naive<EpiWo, false, 0><<<dim3(D / 64, NTOK / 64), 256, 0, stream>>>(U, D, wt_o, D, D, e); }
    k_ln1_router<<<NTOK / 4, 256, 0, stream>>>(out, ada, ln1_g, ln1_b, w_router, b_router, U, tok_e, tok_w, tok_p, list, cnt);
    k_moe_meta<<<1, 64, 0, stream>>>(cnt, meta);
    { EpiGU e; e.meta = meta; e.cnt = cnt; e.list = list; e.bg = b_gate; e.bu = b_up; e.H = H;
      k_gemm_naive<EpiGU, true, 0><<<dim3(D / 64, PMAX / 64), 256, 0, stream>>>(U, D, wt_gu, D, D, e); }
    { EpiDown e; e.meta = meta; e.cnt = cnt; e.list = list; e.bd = b_down; e.tok_w = tok_w; e.YB = YB;
      k_gemm_naive<EpiDown, false, 0><<<dim3(D / 64, PMAX / 64), 256, 0, stream>>>(H, D, wt_dn, D, D, e); }
    k_final<<<NTOK / 4, 256, 0, stream>>>(out, YB, ada, ln2_g, ln2_b);
}
```

```cpp
#include <hip/hip_runtime.h>
#include <stdint.h>
#include <stdio.h>
#include <string.h>

typedef unsigned short bf16_t;
typedef unsigned u32x4 __attribute__((ext_vector_type(4)));

constexpr int NB = 2, S = 8192, D = 1024, NTOK = NB * S;
constexpr int POOLW = 512, PGRP = 128;
constexpr int HD = 64, NH = 12, AW = 768, AOW = 256;
constexpr int INW = POOLW + 3 * AW + 2 * D;
constexpr int NE = 32, TOPK = 4, NASSIGN = NTOK * TOPK;
constexpr int MAXTILES = 288, PMAX = MAXTILES * 256;
constexpr float LN_EPS = 1e-5f;
constexpr float DN_ALPHA = 1.189207115002721f;
constexpr float SW_ALPHA = 1.702f, SW_LIMIT = 7.0f;

constexpr size_t MiB = 1u << 20;
constexpr size_t WS_CTL = 0, CTL_BYTES = 1 * MiB;
constexpr size_t WS_ADA = 1 * MiB;
constexpr size_t WS_ROPE = 2 * MiB;
constexpr size_t WS_TOKE = 3 * MiB;
constexpr size_t WS_TOKW = WS_TOKE + 256 * 1024;
constexpr size_t WS_TOKP = WS_TOKW + 256 * 1024;
constexpr size_t WS_META = WS_TOKP + 256 * 1024;
constexpr size_t WS_LIST = 4 * MiB;
constexpr size_t WS_LISTW = 6 * MiB;
constexpr size_t WS_WIN = 8 * MiB;
constexpr size_t WS_WPOOL = 18 * MiB;
constexpr size_t WS_WCAT = 19 * MiB;
constexpr size_t WS_WO = 21 * MiB;
constexpr size_t WS_WDN = 24 * MiB;
constexpr size_t WS_WGU = 88 * MiB;
constexpr size_t WS_YB = 88 * MiB;
constexpr size_t WS_U = 216 * MiB;
constexpr size_t WS_XP = 248 * MiB;
constexpr size_t WS_Q = 264 * MiB, WS_K = 288 * MiB, WS_V = 312 * MiB;
constexpr size_t WS_GP = 336 * MiB, WS_GA = 368 * MiB;
constexpr size_t WS_H = 248 * MiB;
constexpr size_t WS_ACAT = 400 * MiB;
constexpr size_t WS_LSE = 424 * MiB;
constexpr size_t WS_OG = 426 * MiB;
constexpr size_t WS_MIX = 450 * MiB;
constexpr size_t WS_END = 470 * MiB;
constexpr int CW_CNT = 1024;

__device__ __forceinline__ float bf2f(bf16_t v) { return __uint_as_float((unsigned)v << 16); }
__device__ __forceinline__ bf16_t f2bf(float f) { unsigned u = __float_as_uint(f); return (bf16_t)((u + 0x7fffu + ((u >> 16) & 1u)) >> 16); }
__device__ __forceinline__ float sigmoidf_(float x) { return 1.0f / (1.0f + __expf(-x)); }
__device__ __forceinline__ float wave_sum(float v) {
#pragma unroll
    for (int o = 1; o < 64; o <<= 1) v += __shfl_xor(v, o);
    return v;
}

__device__ __forceinline__ int rowmap(int n, int mode) { return mode == 0 ? n : (256 * (n >> 7) + (n & 127) + (mode == 2 ? 128 : 0)); }
__global__ void __launch_bounds__(256) k_transpose(const float* src, int K, int N, size_t sbatch, bf16_t* dst, int dld, int koff, size_t dbatch, int mode) {
    __shared__ float t[32][33];
    src += (size_t)blockIdx.z * sbatch; dst += (size_t)blockIdx.z * dbatch;
    const int n0 = blockIdx.x * 32, k0 = blockIdx.y * 32, tx = threadIdx.x & 31, ty = threadIdx.x >> 5;
    for (int i = ty; i < 32; i += 8) t[i][tx] = src[(size_t)(k0 + i) * N + n0 + tx];
    __syncthreads();
    for (int i = ty; i < 32; i += 8) dst[(size_t)rowmap(n0 + i, mode) * dld + koff + k0 + tx] = f2bf(t[tx][i]);
}
__global__ void __launch_bounds__(256) k_ada(const float* c, const float* w_ada, const float* b_ada, float* ada) {
    const int j = blockIdx.x * 256 + threadIdx.x, b = blockIdx.y;
    float acc = b_ada[j];
    for (int k = 0; k < D; ++k) { const float cv = c[b * D + k]; acc += (cv * sigmoidf_(cv)) * w_ada[(size_t)k * (6 * D) + j]; }
    ada[b * 6 * D + j] = acc;
}
__constant__ float c_invfreq[8] = {1.0f, 0.1939227432012558f, 0.03760603070259094f, 0.007292664609849453f, 0.0014142135623842478f, 0.00027424818836152554f, 5.318296098266728e-05f, 1.0313386155758053e-05f};
__global__ void __launch_bounds__(256) k_rope(const int* positions, float* rope) {
    const int i = blockIdx.x * 256 + threadIdx.x; if (i >= NTOK * 8) return;
    const int tok = i >> 3, f = i & 7;
    const float ang = (float)positions[tok] * c_invfreq[f];
    rope[tok * 16 + f] = cosf(ang); rope[tok * 16 + 8 + f] = sinf(ang);
}
__global__ void __launch_bounds__(256) k_ln_mod(const float* x, const float* ada, int shift_idx, int scale_idx, bf16_t* U) {
    const int row = blockIdx.x * 4 + (threadIdx.x >> 6), lane = threadIdx.x & 63, b = row / S;
    const float* xr = x + (size_t)row * D;
    float v[16]; float s = 0.f;
#pragma unroll
    for (int j = 0; j < 16; ++j) { v[j] = xr[lane + 64 * j]; s += v[j]; }
    const float mean = wave_sum(s) * (1.f / D); float q = 0.f;
#pragma unroll
    for (int j = 0; j < 16; ++j) { v[j] -= mean; q += v[j] * v[j]; }
    const float rstd = rsqrtf(wave_sum(q) * (1.f / D) + LN_EPS);
    const float* sh = ada + b * 6 * D + shift_idx * D; const float* sc = ada + b * 6 * D + scale_idx * D;
#pragma unroll
    for (int j = 0; j < 16; ++j) { const int c = lane + 64 * j; U[(size_t)row * D + c] = f2bf(v[j] * rstd * (1.f + sc[c]) + sh[c]); }
}

template <class Epi, bool DUAL, int KSPLIT>
__global__ void __launch_bounds__(256) k_gemm_naive(const bf16_t* A, int lda, const bf16_t* Bt, int ldb, int K, Epi epi) {
    __shared__ float As[64][33], Bs[64][33], Bs2[DUAL ? 64 : 1][33];
    const int row0 = blockIdx.y * 64, col0 = blockIdx.x * 64, tid = threadIdx.x, tx = tid & 15, ty = tid >> 4;
    if (!epi.tile_ok(row0)) return;
    const bf16_t* Bb = Bt + epi.b_off(row0);
    const int lr = tid >> 2, lk = (tid & 3) * 8;
    const bf16_t* ap = A + (size_t)epi.a_row(row0 + lr) * lda + lk;
    const bf16_t* bp = Bb + (size_t)epi.b_row(col0 + lr) * ldb + lk;
    float acc[4][4], acc2[4][4];
#pragma unroll
    for (int i = 0; i < 4; ++i)
#pragma unroll
        for (int j = 0; j < 4; ++j) { acc[i][j] = 0.f; acc2[i][j] = 0.f; }
    for (int k0 = 0; k0 < K; k0 += 32) {
        if (KSPLIT > 0 && k0 == KSPLIT) {
#pragma unroll
            for (int i = 0; i < 4; ++i)
#pragma unroll
                for (int j = 0; j < 4; ++j) epi.mid(row0 + ty * 4 + i, col0 + tx * 4 + j, acc[i][j]);
        }
        const u32x4 av = *(const u32x4*)(ap + k0), bv = *(const u32x4*)(bp + k0);
        u32x4 bv2 = {0, 0, 0, 0}; if (DUAL) bv2 = *(const u32x4*)(bp + (size_t)128 * ldb + k0);
        __syncthreads();
#pragma unroll
        for (int j = 0; j < 4; ++j) {
            As[lr][lk + 2 * j] = __uint_as_float(av[j] << 16); As[lr][lk + 2 * j + 1] = __uint_as_float(av[j] & 0xffff0000u);
            Bs[lr][lk + 2 * j] = __uint_as_float(bv[j] << 16); Bs[lr][lk + 2 * j + 1] = __uint_as_float(bv[j] & 0xffff0000u);
            if (DUAL) { Bs2[lr][lk + 2 * j] = __uint_as_float(bv2[j] << 16); Bs2[lr][lk + 2 * j + 1] = __uint_as_float(bv2[j] & 0xffff0000u); }
        }
        __syncthreads();
#pragma unroll 8
        for (int kk = 0; kk < 32; ++kk) {
            float a[4], b[4], b2[4];
#pragma unroll
            for (int i = 0; i < 4; ++i) { a[i] = As[ty * 4 + i][kk]; b[i] = Bs[tx * 4 + i][kk]; b2[i] = DUAL ? Bs2[tx * 4 + i][kk] : 0.f; }
#pragma unroll
            for (int i = 0; i < 4; ++i)
#pragma unroll
                for (int j = 0; j < 4; ++j) { acc[i][j] += a[i] * b[j]; if (DUAL) acc2[i][j] += a[i] * b2[j]; }
        }
    }
#pragma unroll
    for (int i = 0; i < 4; ++i)
#pragma unroll
        for (int j = 0; j < 4; ++j) epi(row0 + ty * 4 + i, col0 + tx * 4 + j, acc[i][j], acc2[i][j]);
}
struct EpiBase {
    __device__ bool tile_ok(int) const { return true; }
    __device__ size_t b_off(int) const { return 0; }
    __device__ int b_row(int n) const { return n; }
    __device__ int a_row(int m) const { return m; }
    __device__ void mid(int, int, float&) const {}
};
struct EpiProj : EpiBase {
    bf16_t *xp, *q, *k, *v, *gp, *ga;
    __device__ void operator()(int m, int n, float a, float) const {
        const bf16_t o = f2bf(a);
        if (n < 512) { xp[(size_t)m * 512 + n] = o; return; } n -= 512;
        if (n < 768) { q[(size_t)m * 768 + n] = o; return; } n -= 768;
        if (n < 768) { k[(size_t)m * 768 + n] = o; return; } n -= 768;
        if (n < 768) { v[(size_t)m * 768 + n] = o; return; } n -= 768;
        if (n < 1024) { gp[(size_t)m * 1024 + n] = o; return; } n -= 1024;
        ga[(size_t)m * 1024 + n] = o;
    }
};
__global__ void __launch_bounds__(256) k_rotary(bf16_t* qk, const float* rope, float scale) {
    const int i = blockIdx.x * 256 + threadIdx.x; if (i >= NTOK * NH * 8) return;
    const int f = i & 7, h = (i >> 3) % NH, tok = i / (8 * NH);
    bf16_t* p = qk + (size_t)tok * AW + h * HD;
    const float c = rope[tok * 16 + f], s = rope[tok * 16 + 8 + f], x1 = bf2f(p[f]), x2 = bf2f(p[f + 8]);
    p[f] = f2bf((x1 * c - x2 * s) * scale); p[f + 8] = f2bf((x2 * c + x1 * s) * scale);
}
__global__ void __launch_bounds__(256) k_scale_rest(bf16_t* q, float scale) {
    const int i = blockIdx.x * 256 + threadIdx.x; if (i >= NTOK * NH * 48) return;
    const int d = 16 + i % 48, h = (i / 48) % NH, tok = i / (48 * NH);
    bf16_t* p = q + (size_t)tok * AW + h * HD + d; *p = f2bf(bf2f(*p) * scale);
}
__global__ void __launch_bounds__(256) k_pool_mix(const bf16_t* xp, bf16_t* mix) {
    const int i = blockIdx.x * 256 + threadIdx.x; if (i >= NTOK * POOLW) return;
    const int c = i & 511, tok = i >> 9, t = tok % S, g = c >> 7, w = 2 << g;
    const int cnt = (t + 1 < w) ? t + 1 : w; float s = 0.f;
    for (int j = 0; j < cnt; ++j) s += bf2f(xp[(size_t)(tok - j) * POOLW + c]);
    mix[i] = f2bf(s / (float)cnt - bf2f(xp[i]));
}
struct EpiPool : EpiBase {
    bf16_t* acat; const float* pscale; int g;
    __device__ void operator()(int m, int n, float a, float) const { acat[(size_t)m * 768 + 256 + g * 128 + n] = f2bf(a * pscale[g * 128 + n]); }
};
__global__ void __launch_bounds__(256) k_attn_naive(const bf16_t* Q, const bf16_t* Kb, const bf16_t* Vb, bf16_t* OG, float* LSE) {
    const int i = blockIdx.x * 256 + threadIdx.x; if (i >= NTOK * NH) return;
    const int h = i % NH, tok = i / NH, b = tok / S, t = tok % S, g = h >> 2, dl = (g == 0) ? 1 : (g == 1 ? 4 : 16);
    float q[64], o[64];
#pragma unroll
    for (int e = 0; e < 64; ++e) { q[e] = bf2f(Q[(size_t)tok * AW + h * HD + e]); o[e] = 0.f; }
    float m = -1e30f, den = 0.f;
    const int jq = t / dl;
    const int nk = (jq < 128) ? jq + 1 : 129;
    for (int j = 0; j < nk; ++j) {
        const int kt = b * S + t - j * dl;
        const bf16_t* kp = Kb + (size_t)kt * AW + h * HD; const bf16_t* vp = Vb + (size_t)kt * AW + h * HD;
        float s = 0.f;
#pragma unroll
        for (int e = 0; e < 64; ++e) s += q[e] * bf2f(kp[e]);
        const float mn = fmaxf(m, s), a = __expf(m - mn), p = __expf(s - mn);
        den = den * a + p;
#pragma unroll
        for (int e = 0; e < 64; ++e) o[e] = o[e] * a + p * bf2f(vp[e]);
        m = mn;
    }
    const float inv = 1.f / den;
#pragma unroll
    for (int e = 0; e < 64; ++e) OG[(size_t)tok * AW + h * HD + e] = f2bf(o[e] * inv);
    LSE[tok * NH + h] = m + __logf(den);
}
__global__ void __launch_bounds__(256) k_merge(const bf16_t* OG, const float* LSE, bf16_t* acat) {
    const int i = blockIdx.x * 256 + threadIdx.x; if (i >= NTOK * AOW) return;
    const int e = i & 63, hs = (i >> 6) & 3, tok = i >> 8;
    const float l0 = LSE[tok * NH + hs], l1 = LSE[tok * NH + 4 + hs], l2 = LSE[tok * NH + 8 + hs];
    const float mx = fmaxf(l0, fmaxf(l1, l2)), w0 = __expf(l0 - mx), w1 = __expf(l1 - mx), w2 = __expf(l2 - mx), inv = 1.f / (w0 + w1 + w2);
    const float v = (w0 * bf2f(OG[(size_t)tok * AW + hs * HD + e]) + w1 * bf2f(OG[(size_t)tok * AW + (4 + hs) * HD + e]) + w2 * bf2f(OG[(size_t)tok * AW + (8 + hs) * HD + e])) * inv;
    acat[(size_t)tok * 768 + hs * HD + e] = f2bf(v);
}
struct EpiMerged : EpiBase {
    const bf16_t *gp, *ga; bf16_t* out;
    __device__ void mid(int m, int n, float& acc) const {
        const float a = bf2f(ga[(size_t)m * D + n]), p = fmaxf(bf2f(gp[(size_t)m * D + n]), -30.f);
        acc *= sigmoidf_(a) * (1.f + __expf(-p));
    }
    __device__ void operator()(int m, int n, float acc, float) const {
        const float p = fmaxf(bf2f(gp[(size_t)m * D + n]), -30.f);
        out[(size_t)m * D + n] = f2bf(acc * sigmoidf_(p));
    }
};
struct EpiWo : EpiBase {
    const float *x, *ada; float* y;
    __device__ void operator()(int m, int n, float acc, float) const {
        const int b = m / S; y[(size_t)m * D + n] = DN_ALPHA * x[(size_t)m * D + n] + (1.f + ada[b * 6 * D + 2 * D + n]) * acc;
    }
};
__global__ void __launch_bounds__(256) k_ln1_router(float* y, const float* ada, const float* g1, const float* b1, const float* w_router, const float* b_router,
                                                    bf16_t* U2, int* tok_e, float* tok_w, int* tok_p, int* list, float* listw, int* cnt) {
    const int row = blockIdx.x * 4 + (threadIdx.x >> 6), lane = threadIdx.x & 63, b = row / S;
    float* yr = y + (size_t)row * D;
    float v[16]; float s = 0.f;
#pragma unroll
    for (int j = 0; j < 16; ++j) { v[j] = yr[lane + 64 * j]; s += v[j]; }
    float mean = wave_sum(s) * (1.f / D), q = 0.f;
#pragma unroll
    for (int j = 0; j < 16; ++j) { v[j] -= mean; q += v[j] * v[j]; }
    float rstd = rsqrtf(wave_sum(q) * (1.f / D) + LN_EPS);
    s = 0.f;
#pragma unroll
    for (int j = 0; j < 16; ++j) { const int c = lane + 64 * j; v[j] = v[j] * rstd * g1[c] + b1[c]; yr[c] = v[j]; s += v[j]; }
    mean = wave_sum(s) * (1.f / D); q = 0.f;
#pragma unroll
    for (int j = 0; j < 16; ++j) { v[j] -= mean; q += v[j] * v[j]; }
    rstd = rsqrtf(wave_sum(q) * (1.f / D) + LN_EPS);
    const float* sh = ada + b * 6 * D + 3 * D; const float* sc = ada + b * 6 * D + 4 * D;
#pragma unroll
    for (int j = 0; j < 16; ++j) { const int c = lane + 64 * j; v[j] = v[j] * rstd * (1.f + sc[c]) + sh[c]; U2[(size_t)row * D + c] = f2bf(v[j]); }
    float lg[NE];
#pragma unroll
    for (int e = 0; e < NE; ++e) lg[e] = 0.f;
#pragma unroll
    for (int j = 0; j < 16; ++j) { const float* wr = w_router + (size_t)(lane + 64 * j) * NE;
#pragma unroll
        for (int e = 0; e < NE; ++e) lg[e] += v[j] * wr[e]; }
#pragma unroll
    for (int e = 0; e < NE; ++e) lg[e] = wave_sum(lg[e]) + b_router[e];
    if (lane == 0) {
        int idx[4]; float val[4]; unsigned used = 0u;
#pragma unroll
        for (int k = 0; k < 4; ++k) { int bi = 0; float bv = -3.4e38f;
#pragma unroll
            for (int e = 0; e < NE; ++e) if (!((used >> e) & 1u) && lg[e] > bv) { bv = lg[e]; bi = e; }
            used |= 1u << bi; idx[k] = bi; val[k] = bv; }
        float den = 0.f, p[4];
#pragma unroll
        for (int k = 0; k < 4; ++k) { p[k] = __expf(val[k] - val[0]); den += p[k]; }
#pragma unroll
        for (int k = 0; k < 4; ++k) {
            const int pos = atomicAdd(&cnt[idx[k]], 1);
            tok_e[row * 4 + k] = idx[k]; tok_w[row * 4 + k] = p[k] / den; tok_p[row * 4 + k] = pos;
            list[idx[k] * NTOK + pos] = row * 4 + k; listw[idx[k] * NTOK + pos] = p[k] / den;
        }
    }
}
__global__ void k_moe_meta(const int* cnt, int* meta) {
    if (threadIdx.x == 0) { int off = 0, nt = 0;
        for (int e = 0; e < NE; ++e) { meta[e] = off; const int t = (cnt[e] + 255) / 256; for (int i = 0; i < t; ++i) meta[128 + nt + i] = e; nt += t; off += t * 256; }
        meta[32] = off; meta[64] = nt; }
}
struct EpiMoeBase {
    const int *meta, *cnt, *list;
    __device__ bool tile_ok(int row0) const { return (row0 >> 8) < meta[64]; }
    __device__ int expert(int row0) const { return meta[128 + (row0 >> 8)]; }
    __device__ int lidx(int m) const { const int e = expert(m), pos = m - meta[e]; return pos < cnt[e] ? e * NTOK + pos : -1; }
    __device__ int src(int m) const { const int p = lidx(m); return p < 0 ? -1 : list[p]; }
    __device__ void mid(int, int, float&) const {}
};
struct EpiGU : EpiMoeBase {
    const float *bg, *bu; bf16_t* H;
    __device__ size_t b_off(int row0) const { return (size_t)expert(row0) * 2048 * 1024; }
    __device__ int b_row(int n) const { return 256 * (n >> 7) + (n & 127); }
    __device__ int a_row(int m) const { const int s = src(m); return s < 0 ? 0 : (s >> 2); }
    __device__ void operator()(int m, int n, float g, float u) const {
        const int e = expert(m);
        g += bg[e * 1024 + n]; u += bu[e * 1024 + n];
        g = fminf(g, SW_LIMIT); u = fminf(fmaxf(u, -SW_LIMIT), SW_LIMIT);
        H[(size_t)m * 1024 + n] = f2bf(g * sigmoidf_(SW_ALPHA * g) * (u + 1.f));
    }
};
struct EpiDown : EpiMoeBase {
    const float *bd, *listw; bf16_t* YB;
    __device__ size_t b_off(int row0) const { return (size_t)expert(row0) * 1024 * 1024; }
    __device__ int b_row(int n) const { return n; }
    __device__ int a_row(int m) const { return m; }
    __device__ void operator()(int m, int n, float a, float) const {
        const int p = lidx(m); if (p < 0) return;
        YB[(size_t)list[p] * 1024 + n] = f2bf((a + bd[expert(m) * 1024 + n]) * listw[p]);
    }
};
__global__ void __launch_bounds__(256) k_final(float* x1, const bf16_t* YB, const float* ada, const float* g2, const float* b2) {
    const int row = blockIdx.x * 4 + (threadIdx.x >> 6), lane = threadIdx.x & 63, b = row / S;
    float* xr = x1 + (size_t)row * D; const float* gate = ada + b * 6 * D + 5 * D;
    float v[16]; float s = 0.f;
#pragma unroll
    for (int j = 0; j < 16; ++j) { const int c = lane + 64 * j; float f = 0.f;
        for (int k = 0; k < 4; ++k) f += bf2f(YB[((size_t)row * 4 + k) * D + c]);
        v[j] = DN_ALPHA * xr[c] + (1.f + gate[c]) * f; s += v[j]; }
    const float mean = wave_sum(s) * (1.f / D); float q = 0.f;
#pragma unroll
    for (int j = 0; j < 16; ++j) { v[j] -= mean; q += v[j] * v[j]; }
    const float rstd = rsqrtf(wave_sum(q) * (1.f / D) + LN_EPS);
#pragma unroll
    for (int j = 0; j < 16; ++j) { const int c = lane + 64 * j; xr[c] = v[j] * rstd * g2[c] + b2[c]; }
}


#define LAS __attribute__((address_space(3)))
#define GAS __attribute__((address_space(1)))
typedef short bf16x8 __attribute__((ext_vector_type(8)));
typedef short s16x4 __attribute__((ext_vector_type(4)));
typedef float f32x4 __attribute__((ext_vector_type(4)));
typedef float f32x2 __attribute__((ext_vector_type(2)));
typedef unsigned u32x2 __attribute__((ext_vector_type(2)));
typedef GAS unsigned gu32;
#define RLX_AGENT __ATOMIC_RELAXED, __HIP_MEMORY_SCOPE_AGENT
#define LDS_WAIT() asm volatile("s_waitcnt lgkmcnt(0)" ::: "memory")
#define VM_WAIT() asm volatile("s_waitcnt vmcnt(0)" ::: "memory")

constexpr int NWAVES = 8;
constexpr int RING_BYTES = 131072;
constexpr int QREG_OFF = RING_BYTES;
constexpr int TAB_OFF = 147456;
constexpr int LDS_BYTES = 163840;
constexpr int T_MISC = 0;
constexpr int T_TILE_E = 256;
constexpr int T_TILE0 = 256 + 1280;
constexpr int T_CNT = T_TILE0 + 160;
constexpr int T_NT = T_CNT + 128;
constexpr int T_LCNT = T_NT + 16;
constexpr int T_GBASE = T_LCNT + 128;
constexpr int T_REC = T_GBASE + 128;
constexpr int T_WSCR = T_REC + 3072;
constexpr int T_END = T_WSCR + 2048;
static_assert(TAB_OFF + T_END <= LDS_BYTES, "LDS map");

__device__ __forceinline__ unsigned cvt_pk_bf16(float lo, float hi) { unsigned r; asm volatile("v_cvt_pk_bf16_f32 %0, %1, %2" : "=v"(r) : "v"(lo), "v"(hi)); return r; }
__device__ __forceinline__ float bflo(unsigned w) { return __uint_as_float(w << 16); }
__device__ __forceinline__ float bfhi(unsigned w) { return __uint_as_float(w & 0xffff0000u); }
__device__ __forceinline__ float fast_sigmoid(float x) { return __builtin_amdgcn_rcpf(1.0f + __expf(-x)); }

#define XB_TMO      128
#define XB_XCNT(j)  (256  + 64 * (j))
#define XB_XSUB(j)  (1280 + 64 * (j))
#define XB_XGEN(j)  (2304 + 64 * (j))
#define XB_TOP      3328
#define XB_TOPGEN   3392
#define XCD_BAR_WORDS 3456
#define XB_SPIN_CAP (1u << 18)
__device__ __forceinline__ unsigned xb_ld(unsigned* p)              { return __hip_atomic_load(p, __ATOMIC_RELAXED, __HIP_MEMORY_SCOPE_AGENT); }
__device__ __forceinline__ unsigned xb_add(unsigned* p, unsigned v) { return __hip_atomic_fetch_add(p, v, __ATOMIC_RELAXED, __HIP_MEMORY_SCOPE_AGENT); }
__device__ __forceinline__ unsigned xb_xcc_id() { return (unsigned)__builtin_amdgcn_s_getreg((3 << 11) | 20) & 0xFu; }
#define XB_SPIN(cond, bar) do { unsigned _sp = 0; while (cond) { __builtin_amdgcn_s_sleep(1); \
    if ((++_sp & 255u) == 0u) { if (xb_ld(&(bar)[XB_TMO])) break; if (_sp > XB_SPIN_CAP) { atomicAdd(&(bar)[XB_TMO], 1u); break; } } } } while (0)
struct XcdBarrier { unsigned* bar; unsigned x; volatile LAS unsigned* st; };
__device__ __forceinline__ XcdBarrier xcd_barrier_post(unsigned* bar, volatile LAS unsigned* st) {
    XcdBarrier b; b.bar = bar; b.x = xb_xcc_id(); b.st = st;
    if (threadIdx.x == 0) (void)xb_add(&bar[XB_XCNT(b.x)], 1u);
    return b;
}
__device__ __forceinline__ void xcd_barrier_complete(unsigned* bar, unsigned x, unsigned& nloc, unsigned& nx) {
    const unsigned G = gridDim.x * gridDim.y * gridDim.z;
    unsigned sum, cnt, mine, sp = 0u;
    for (;;) {
        sum = 0u; cnt = 0u; mine = 0u;
#pragma unroll
        for (unsigned j = 0; j < 16; ++j) { const unsigned c = xb_ld(&bar[XB_XCNT(j)]); sum += c; cnt += (c > 0u) ? 1u : 0u; mine = (j == x) ? c : mine; }
        if (sum == G) break;
        __builtin_amdgcn_s_sleep(1);
        if ((++sp & 255u) == 0u) { if (xb_ld(&bar[XB_TMO])) break; if (sp > XB_SPIN_CAP) { atomicAdd(&bar[XB_TMO], 1u); break; } }
    }
    nloc = mine > 0u ? mine : 1u; nx = cnt > 0u ? cnt : 1u;
}
__device__ __forceinline__ void xcd_barrier(const XcdBarrier& b) {
    asm volatile("s_waitcnt vmcnt(0)" ::: "memory");
    __syncthreads();
    if (threadIdx.x == 0) {
        unsigned* bar = b.bar;
        __builtin_amdgcn_s_waitcnt(0);
        unsigned nloc = b.st[0], nx = b.st[1];
        if (nloc == 0u) { xcd_barrier_complete(bar, b.x, nloc, nx); b.st[0] = nloc; b.st[1] = nx; }
        const unsigned old = xb_add(&bar[XB_XSUB(b.x)], 1u);
        const unsigned gen = old / nloc;
        if (old + 1u == (gen + 1u) * nloc) {
            __builtin_amdgcn_fence(__ATOMIC_RELEASE, "agent");
            asm volatile("s_waitcnt vmcnt(0)" ::: "memory");
            const unsigned og = xb_add(&bar[XB_TOP], 1u);
            const unsigned tg = og / nx;
            if (og + 1u == (tg + 1u) * nx) xb_add(&bar[XB_TOPGEN], 1u);
            else XB_SPIN(xb_ld(&bar[XB_TOPGEN]) == tg, bar);
            __builtin_amdgcn_fence(__ATOMIC_ACQUIRE, "agent");
            xb_add(&bar[XB_XGEN(b.x)], 1u);
            asm volatile("s_waitcnt vmcnt(0)" ::: "memory");
        } else {
            XB_SPIN(xb_ld(&bar[XB_XGEN(b.x)]) == gen, bar);
            __builtin_amdgcn_fence(__ATOMIC_ACQUIRE, "agent");
            asm volatile("s_waitcnt vmcnt(0)" ::: "memory");
        }
    }
    __syncthreads();
}

namespace pg8 {
constexpr int BM = 256, BK = 64, HALF = 128, HTB = HALF * BK * 2, STAGE_BYTES = 8 * HTB, NXCD = 8, WGM = 8;
__host__ __device__ __forceinline__ int lds_byte(int r, int c) { const int st = (r >> 4) * 2 + (c >> 5), rr = r & 15, cc = c & 31, ob = rr * 64 + cc * 2; return st * 1024 + (ob ^ (((ob >> 9) & 1) << 5)); }
__host__ __device__ __forceinline__ void stage_rc(int b, int& R, int& C) { const int st = b / 1024, sb = b % 1024, swz = sb ^ (((sb >> 9) & 1) << 5); R = (st >> 1) * 16 + swz / 64; C = (st & 1) * 32 + (swz % 64) / 2; }
__host__ __device__ __forceinline__ int perm32(int rho) { const int n = rho >> 4, i = rho & 15; return 8 * (i >> 2) + 4 * n + (i & 3); }
struct Unit { int pm, pn; };
struct StaticOrder {
    int nM, nN, nwg, G, c;
    __device__ void init(int M, int N, int G_, int c_) { nM = M / BM; nN = N / BM; nwg = nM * nN; G = G_; c = c_; }
    __device__ bool next(int i, Unit& u) const {
        const long L = (long)i * G + c; if (L >= nwg) return false;
        int wgid = (int)L; { const int q = nwg / NXCD, r = nwg % NXCD, xcd = wgid % NXCD, off = wgid / NXCD; wgid = (xcd < r ? xcd * (q + 1) : r * (q + 1) + (xcd - r) * q) + off; }
        const int nig = WGM * nN, gid = wgid / nig, fm = gid * WGM, gsz = (nM - fm) < WGM ? (nM - fm) : WGM;
        u.pm = fm + ((wgid % nig) % gsz); u.pn = (wgid % nig) / gsz; return true;
    }
};
struct MoeOrder {
    int nN, nunits, G, c;
    __device__ void init(int ntiles, int nN_, int G_, int c_) { nN = nN_; nunits = ntiles * nN_; G = G_; c = c_; }
    __device__ bool next(int i, Unit& u) const { const int L = i * G + c; if (L >= nunits) return false; u.pm = L / nN; u.pn = L % nN; return true; }
};

template <class Prob, class Epi, class Sched, bool ALIGN_EPI>
__device__ __forceinline__ void gemm_phase(LAS unsigned char* lds, const Prob& P, const Sched& S, const Epi& E) {
    const int tid = threadIdx.x, wid = __builtin_amdgcn_readfirstlane(tid >> 6), lane = tid & 63, wr = wid >> 2, wc = wid & 3, fr = lane & 15, fq = lane >> 4;
    constexpr int K = Prob::K, nt = K / BK;
    static_assert(nt % 2 == 0 && nt >= 4, "K must be a multiple of 128");
    unsigned voffB[2]; int sR[2], sC[2];
#pragma unroll
    for (int i = 0; i < 2; ++i) { int R, C; stage_rc(tid * 16 + i * 8192, R, C); const int Rb = Epi::PERM ? ((R & ~31) + perm32(R & 31)) : R;
        voffB[i] = (unsigned)(Rb * K + C) * 2u; sR[i] = R; sC[i] = C; }
    constexpr size_t kstep = (size_t)(BK * 2);
    constexpr size_t hstepB = (size_t)HALF * K * 2;
    const unsigned ldsw = (unsigned)wid * 1024u;
    const int aoff = lds_byte(wr * 64 + fr, fq * 8), boff = lds_byte(wc * 32 + fr, fq * 8);
#define PG8_SA(b, h) (((b) * 2 + (h)) * HTB)
#define PG8_SB(b, h) ((4 + (b) * 2 + (h)) * HTB)
#define PG8_STAGE(bufoff, gbase, voff) do { _Pragma("unroll") for (int _i = 0; _i < 2; ++_i) \
        __builtin_amdgcn_global_load_lds((const unsigned*)((const char*)(gbase) + (voff)[_i]), (LAS unsigned*)(lds + (bufoff) + ldsw + _i * 8192), 16, 0, 0); } while (0)
#define PG8_LDA(dst, b, h) do { _Pragma("unroll") for (int m = 0; m < 4; ++m) _Pragma("unroll") for (int k = 0; k < 2; ++k) dst[m][k] = *(const LAS bf16x8*)(lds + PG8_SA(b, h) + aoff + m * 2048 + k * 1024); } while (0)
#define PG8_LDB(dst, b, h) do { _Pragma("unroll") for (int n = 0; n < 2; ++n) _Pragma("unroll") for (int k = 0; k < 2; ++k) dst[n][k] = *(const LAS bf16x8*)(lds + PG8_SB(b, h) + boff + n * 2048 + k * 1024); } while (0)
#define PG8_MMA(ai, bj, At, Bt) do { __builtin_amdgcn_s_setprio(1); _Pragma("unroll") for (int m = 0; m < 4; ++m) _Pragma("unroll") for (int n = 0; n < 2; ++n) _Pragma("unroll") for (int k = 0; k < 2; ++k) \
        acc[ai][bj][m][n] = __builtin_amdgcn_mfma_f32_16x16x32_bf16(Bt[n][k], At[m][k], acc[ai][bj][m][n], 0, 0, 0); __builtin_amdgcn_s_setprio(0); } while (0)
#define PG8_WAIT_V(n) asm volatile("s_waitcnt vmcnt(" #n ")" ::: "memory")
#define PG8_WAIT_L(n) asm volatile("s_waitcnt lgkmcnt(" #n ")" ::: "memory")
#define PG8_BAR __builtin_amdgcn_s_barrier()
#define PG8_SCHED __builtin_amdgcn_sched_barrier(0)
    Unit cur, nxt; int ui = 0;
    if (!S.next(0, cur)) return;
    f32x4 acc[2][2][4][2];
#pragma unroll
    for (int a = 0; a < 2; ++a)
#pragma unroll
        for (int b = 0; b < 2; ++b)
#pragma unroll
            for (int m = 0; m < 4; ++m)
#pragma unroll
                for (int n = 0; n < 2; ++n) acc[a][b][m][n] = (f32x4){0.f, 0.f, 0.f, 0.f};
    bf16x8 At[4][2], B0[2][2], B1[2][2];
    unsigned cv0[2], cv1[2], nv0[2], nv1[2];
    const char* cA = P.a_ptr(cur); const char* cB = P.b_ptr(cur);
    P.a_voff(cur, sR, sC, cv0, cv1);
    PG8_STAGE(PG8_SB(0, 0), cB, voffB); PG8_STAGE(PG8_SB(0, 1), cB + hstepB, voffB); PG8_STAGE(PG8_SA(0, 0), cA, cv0); PG8_STAGE(PG8_SA(0, 1), cA, cv1);
    if (wr == 1) PG8_BAR;
    PG8_WAIT_V(2); PG8_BAR;
    PG8_STAGE(PG8_SB(1, 0), cB + kstep, voffB); PG8_STAGE(PG8_SA(1, 0), cA + kstep, cv0); PG8_STAGE(PG8_SB(1, 1), cB + hstepB + kstep, voffB);
    PG8_WAIT_V(6); PG8_BAR;
    for (;;) {
        const bool has_next = S.next(ui + 1, nxt);
        const char* nA = has_next ? P.a_ptr(nxt) : cA; const char* nB = has_next ? P.b_ptr(nxt) : cB;
        if (has_next) P.a_voff(nxt, sR, sC, nv0, nv1); else { nv0[0] = cv0[0]; nv0[1] = cv0[1]; nv1[0] = cv1[0]; nv1[1] = cv1[1]; }
        for (int t = 0; t < nt; t += 2) {
            if constexpr (Epi::HAS_MID) { if (t == Epi::MID_T) E.mid(acc, cur, wr, wc, fr, fq); }
            const bool last = (t == nt - 2);
            const char* a1 = cA + (size_t)(t + 1) * kstep;
            const char* a2 = last ? nA : cA + (size_t)(t + 2) * kstep; const char* b2 = last ? nB : cB + (size_t)(t + 2) * kstep;
            const char* a3 = a2 + kstep; const char* b3 = b2 + kstep;
            unsigned v20[2], v21[2];
            v20[0] = last ? nv0[0] : cv0[0]; v20[1] = last ? nv0[1] : cv0[1]; v21[0] = last ? nv1[0] : cv1[0]; v21[1] = last ? nv1[1] : cv1[1];
            PG8_LDB(B0, 0, 0); PG8_LDB(B1, 0, 1); PG8_SCHED; PG8_LDA(At, 0, 0); PG8_STAGE(PG8_SA(1, 1), a1, cv1);
            PG8_WAIT_V(8); PG8_WAIT_L(0); PG8_BAR; PG8_MMA(0, 0, At, B0); PG8_MMA(0, 1, At, B1); PG8_BAR; PG8_SCHED;
            PG8_LDA(At, 0, 1); PG8_STAGE(PG8_SB(0, 0), b2, voffB); PG8_STAGE(PG8_SB(0, 1), b2 + hstepB, voffB); PG8_STAGE(PG8_SA(0, 0), a2, v20);
            PG8_WAIT_V(8); PG8_WAIT_L(0); PG8_BAR; PG8_MMA(1, 0, At, B0); PG8_MMA(1, 1, At, B1); PG8_BAR; PG8_SCHED;
            PG8_LDB(B0, 1, 0); PG8_LDB(B1, 1, 1); PG8_SCHED; PG8_LDA(At, 1, 0); PG8_STAGE(PG8_SA(0, 1), a2, v21);
            PG8_WAIT_V(8); PG8_WAIT_L(0); PG8_BAR; PG8_MMA(0, 0, At, B0); PG8_MMA(0, 1, At, B1); PG8_BAR; PG8_SCHED;
            PG8_LDA(At, 1, 1); PG8_STAGE(PG8_SB(1, 0), b3, voffB); PG8_STAGE(PG8_SB(1, 1), b3 + hstepB, voffB); PG8_STAGE(PG8_SA(1, 0), a3, v20);
            PG8_WAIT_V(8); PG8_WAIT_L(0); PG8_BAR; PG8_MMA(1, 0, At, B0); PG8_MMA(1, 1, At, B1); PG8_BAR; PG8_SCHED;
        }
        if constexpr (ALIGN_EPI) { if (wr == 0) PG8_BAR; }
        E(acc, cur, wr, wc, fr, fq);
        if (!has_next) break;
#pragma unroll
        for (int a = 0; a < 2; ++a)
#pragma unroll
            for (int b = 0; b < 2; ++b)
#pragma unroll
                for (int m = 0; m < 4; ++m)
#pragma unroll
                    for (int n = 0; n < 2; ++n) acc[a][b][m][n] = (f32x4){0.f, 0.f, 0.f, 0.f};
        cur = nxt; cA = nA; cB = nB; ++ui;
        cv0[0] = nv0[0]; cv0[1] = nv0[1]; cv1[0] = nv1[0]; cv1[1] = nv1[1];
        if constexpr (ALIGN_EPI) { if (wr == 1) PG8_BAR; }
    }
    PG8_WAIT_V(0);
    if constexpr (!ALIGN_EPI) { if (wr == 0) PG8_BAR; }
    PG8_BAR;
#undef PG8_SA
#undef PG8_SB
#undef PG8_STAGE
#undef PG8_LDA
#undef PG8_LDB
#undef PG8_MMA
#undef PG8_WAIT_V
#undef PG8_WAIT_L
#undef PG8_BAR
#undef PG8_SCHED
}

template <int K_> struct ProbDense {
    static constexpr int K = K_;
    const bf16_t* A; const bf16_t* Bt;
    __device__ __forceinline__ const char* a_ptr(const Unit& u) const { return (const char*)A + (size_t)u.pm * BM * K * 2; }
    __device__ __forceinline__ const char* b_ptr(const Unit& u) const { return (const char*)Bt + (size_t)u.pn * BM * K * 2; }
    __device__ __forceinline__ void a_voff(const Unit&, const int (&R)[2], const int (&C)[2], unsigned (&v0)[2], unsigned (&v1)[2]) const {
#pragma unroll
        for (int i = 0; i < 2; ++i) { v0[i] = (unsigned)(R[i] * K + C[i]) * 2u; v1[i] = (unsigned)((R[i] + HALF) * K + C[i]) * 2u; }
    }
};
struct MoeTabs { const LAS int* tile_e; const LAS int* tile0; const LAS int* cnt; };
struct ProbGU {
    static constexpr int K = 1024;
    const bf16_t* U2; const bf16_t* W; const int* list; MoeTabs T;
    __device__ __forceinline__ const char* a_ptr(const Unit&) const { return (const char*)U2; }
    __device__ __forceinline__ const char* b_ptr(const Unit& u) const { const int e = T.tile_e[u.pm]; return (const char*)W + ((size_t)e * 2048 + (size_t)u.pn * BM) * K * 2; }
    __device__ __forceinline__ void a_voff(const Unit& u, const int (&R)[2], const int (&C)[2], unsigned (&v0)[2], unsigned (&v1)[2]) const {
        const int e = T.tile_e[u.pm], p0 = (u.pm - T.tile0[e]) * BM, n = T.cnt[e]; const int* L = list + (size_t)e * NTOK;
#pragma unroll
        for (int i = 0; i < 2; ++i) {
            const int pa = p0 + R[i], pb = p0 + R[i] + HALF;
            const int ta = pa < n ? (L[pa] >> 2) : 0, tb = pb < n ? (L[pb] >> 2) : 0;
            v0[i] = (unsigned)(ta * K + C[i]) * 2u; v1[i] = (unsigned)(tb * K + C[i]) * 2u;
        }
    }
};
struct ProbDown {
    static constexpr int K = 1024;
    const bf16_t* H; const bf16_t* W; MoeTabs T;
    __device__ __forceinline__ const char* a_ptr(const Unit& u) const { return (const char*)H + (size_t)u.pm * BM * K * 2; }
    __device__ __forceinline__ const char* b_ptr(const Unit& u) const { const int e = T.tile_e[u.pm]; return (const char*)W + ((size_t)e * 1024 + (size_t)u.pn * BM) * K * 2; }
    __device__ __forceinline__ void a_voff(const Unit&, const int (&R)[2], const int (&C)[2], unsigned (&v0)[2], unsigned (&v1)[2]) const {
#pragma unroll
        for (int i = 0; i < 2; ++i) { v0[i] = (unsigned)(R[i] * K + C[i]) * 2u; v1[i] = (unsigned)((R[i] + HALF) * K + C[i]) * 2u; }
    }
};

typedef f32x4 Acc[2][2][4][2];
struct EpiProj {
    static constexpr bool PERM = true, HAS_MID = false; static constexpr int MID_T = -1;
    bf16_t *xp, *q, *k, *v, *gp, *ga; const float* rope;
    __device__ __forceinline__ void mid(Acc&, const Unit&, int, int, int, int) const {}
    __device__ __forceinline__ void operator()(const Acc& acc, const Unit& u, int wr, int wc, int fr, int fq) const {
        const int pn = u.pn; bf16_t* O; int ldc, ct; bool rot = false; float sc = 1.f;
        if (pn < 2) { O = xp; ldc = 512; ct = pn; } else if (pn < 5) { O = q; ldc = 768; ct = pn - 2; rot = true; sc = 0.125f; }
        else if (pn < 8) { O = k; ldc = 768; ct = pn - 5; rot = true; } else if (pn < 11) { O = v; ldc = 768; ct = pn - 8; }
        else if (pn < 15) { O = gp; ldc = 1024; ct = pn - 11; } else { O = ga; ldc = 1024; ct = pn - 15; }
        rot = rot && ((wc & 1) == 0);
        const int row0 = u.pm * BM + wr * 64 + fr, col0 = ct * BM + wc * 32 + 8 * fq;
        const float sgn = (fq == 0) ? -1.f : 1.f; const bool act = fq < 2;
#pragma unroll
        for (int ai = 0; ai < 2; ++ai)
#pragma unroll
            for (int m = 0; m < 4; ++m) {
                const int row = row0 + ai * HALF + m * 16;
                f32x4 c0 = {1.f, 1.f, 1.f, 1.f}, c1 = c0, s0 = {0.f, 0.f, 0.f, 0.f}, s1 = s0;
                if (rot) { const f32x4* rp = (const f32x4*)(rope + (size_t)row * 16); c0 = rp[0]; c1 = rp[1]; s0 = rp[2]; s1 = rp[3]; }
                bf16_t* rowp = O + (size_t)row * ldc + col0;
#pragma unroll
                for (int bj = 0; bj < 2; ++bj) {
                    f32x4 v0 = acc[ai][bj][m][0], v1 = acc[ai][bj][m][1];
                    if (rot) {
                        f32x4 p0, p1;
#pragma unroll
                        for (int j = 0; j < 4; ++j) { p0[j] = __shfl_xor(v0[j], 16); p1[j] = __shfl_xor(v1[j], 16); }
                        if (act) { v0 = v0 * c0 + (p0 * s0) * sgn; v1 = v1 * c1 + (p1 * s1) * sgn; }
                    }
                    v0 = v0 * sc; v1 = v1 * sc;
                    u32x4 w; w.x = cvt_pk_bf16(v0[0], v0[1]); w.y = cvt_pk_bf16(v0[2], v0[3]); w.z = cvt_pk_bf16(v1[0], v1[1]); w.w = cvt_pk_bf16(v1[2], v1[3]);
                    *(u32x4*)(rowp + bj * HALF) = w;
                }
            }
    }
};
struct EpiMerged {
    static constexpr bool PERM = true, HAS_MID = true; static constexpr int MID_T = 4;
    const bf16_t *gp, *ga; bf16_t* out;
    __device__ __forceinline__ void mid(Acc& acc, const Unit& u, int wr, int wc, int fr, int fq) const {
        int row0 = u.pm * BM + wr * 64 + fr; const int col0 = u.pn * BM + wc * 32 + 8 * fq;
        asm volatile("" : "+v"(row0));
#pragma unroll
        for (int ai = 0; ai < 2; ++ai)
#pragma unroll
            for (int m = 0; m < 4; ++m) {
                const size_t off = (size_t)(row0 + ai * HALF + m * 16) * D + col0;
#pragma unroll
                for (int bj = 0; bj < 2; ++bj) {
                    const u32x4 a = *(const u32x4*)(ga + off + bj * HALF), p = *(const u32x4*)(gp + off + bj * HALF);
                    f32x4 f0, f1;
#pragma unroll
                    for (int j = 0; j < 2; ++j) {
                        f0[2 * j] = fast_sigmoid(bflo(a[j])) * (1.f + __expf(-fmaxf(bflo(p[j]), -30.f)));
                        f0[2 * j + 1] = fast_sigmoid(bfhi(a[j])) * (1.f + __expf(-fmaxf(bfhi(p[j]), -30.f)));
                        f1[2 * j] = fast_sigmoid(bflo(a[2 + j])) * (1.f + __expf(-fmaxf(bflo(p[2 + j]), -30.f)));
                        f1[2 * j + 1] = fast_sigmoid(bfhi(a[2 + j])) * (1.f + __expf(-fmaxf(bfhi(p[2 + j]), -30.f)));
                    }
                    acc[ai][bj][m][0] *= f0; acc[ai][bj][m][1] *= f1;
                    asm volatile("" : "+v"(acc[ai][bj][m][0]), "+v"(acc[ai][bj][m][1]) :: "memory");
                }
            }
    }
    __device__ __forceinline__ void operator()(const Acc& acc, const Unit& u, int wr, int wc, int fr, int fq) const {
        const int row0 = u.pm * BM + wr * 64 + fr, col0 = u.pn * BM + wc * 32 + 8 * fq;
#pragma unroll
        for (int ai = 0; ai < 2; ++ai)
#pragma unroll
            for (int m = 0; m < 4; ++m) {
                const size_t off = (size_t)(row0 + ai * HALF + m * 16) * D + col0;
#pragma unroll
                for (int bj = 0; bj < 2; ++bj) {
                    const u32x4 p = *(const u32x4*)(gp + off + bj * HALF);
                    f32x4 v0 = acc[ai][bj][m][0], v1 = acc[ai][bj][m][1];
#pragma unroll
                    for (int j = 0; j < 2; ++j) {
                        v0[2 * j] *= fast_sigmoid(fmaxf(bflo(p[j]), -30.f)); v0[2 * j + 1] *= fast_sigmoid(fmaxf(bfhi(p[j]), -30.f));
                        v1[2 * j] *= fast_sigmoid(fmaxf(bflo(p[2 + j]), -30.f)); v1[2 * j + 1] *= fast_sigmoid(fmaxf(bfhi(p[2 + j]), -30.f));
                    }
                    u32x4 w; w.x = cvt_pk_bf16(v0[0], v0[1]); w.y = cvt_pk_bf16(v0[2], v0[3]); w.z = cvt_pk_bf16(v1[0], v1[1]); w.w = cvt_pk_bf16(v1[2], v1[3]);
                    *(u32x4*)(out + off + bj * HALF) = w;
                }
                asm volatile("" ::: "memory");
            }
    }
};
struct EpiWo {
    static constexpr bool PERM = false, HAS_MID = false; static constexpr int MID_T = -1;
    const float *x, *ada; float* y;
    __device__ __forceinline__ void mid(Acc&, const Unit&, int, int, int, int) const {}
    __device__ __forceinline__ void operator()(const Acc& acc, const Unit& u, int wr, int wc, int fr, int fq) const {
        const int row0 = u.pm * BM + wr * 64 + fr, col0 = u.pn * BM + wc * 32 + 4 * fq;
        const float* gate = ada + ((u.pm * BM) / S) * 6 * D + 2 * D;
        f32x4 gv[2][2];
#pragma unroll
        for (int bj = 0; bj < 2; ++bj)
#pragma unroll
            for (int n = 0; n < 2; ++n) gv[bj][n] = *(const f32x4*)(gate + col0 + bj * HALF + n * 16) + 1.0f;
#pragma unroll
        for (int ai = 0; ai < 2; ++ai)
#pragma unroll
            for (int m = 0; m < 4; ++m) {
                const size_t off = (size_t)(row0 + ai * HALF + m * 16) * D + col0;
#pragma unroll
                for (int bj = 0; bj < 2; ++bj)
#pragma unroll
                    for (int n = 0; n < 2; ++n) {
                        const f32x4 xv = *(const f32x4*)(x + off + bj * HALF + n * 16);
                        *(f32x4*)(y + off + bj * HALF + n * 16) = xv * DN_ALPHA + gv[bj][n] * acc[ai][bj][m][n];
                    }
            }
    }
};
struct EpiGU {
    static constexpr bool PERM = true, HAS_MID = false; static constexpr int MID_T = -1;
    const float *bg, *bu; bf16_t* H; MoeTabs T;
    __device__ __forceinline__ void mid(Acc&, const Unit&, int, int, int, int) const {}
    __device__ __forceinline__ void operator()(const Acc& acc, const Unit& u, int wr, int wc, int fr, int fq) const {
        const int e = T.tile_e[u.pm], col0 = u.pn * HALF + wc * 32 + 8 * fq, row0 = u.pm * BM + wr * 64 + fr;
        const f32x4 bg0 = *(const f32x4*)(bg + e * 1024 + col0), bg1 = *(const f32x4*)(bg + e * 1024 + col0 + 4);
        const f32x4 bu0 = *(const f32x4*)(bu + e * 1024 + col0), bu1 = *(const f32x4*)(bu + e * 1024 + col0 + 4);
#pragma unroll
        for (int ai = 0; ai < 2; ++ai)
#pragma unroll
            for (int m = 0; m < 4; ++m) {
                f32x4 g0 = acc[ai][0][m][0] + bg0, g1 = acc[ai][0][m][1] + bg1, u0 = acc[ai][1][m][0], u1 = acc[ai][1][m][1];
                f32x4 h0, h1;
#pragma unroll
                for (int j = 0; j < 4; ++j) {
                    const float ga = fminf(g0[j], SW_LIMIT), gb = fminf(g1[j], SW_LIMIT);
                    const float ua = fminf(fmaxf(u0[j] + bu0[j], -SW_LIMIT), SW_LIMIT) + 1.0f, ub = fminf(fmaxf(u1[j] + bu1[j], -SW_LIMIT), SW_LIMIT) + 1.0f;
                    h0[j] = ga * fast_sigmoid(SW_ALPHA * ga) * ua; h1[j] = gb * fast_sigmoid(SW_ALPHA * gb) * ub;
                }
                u32x4 w; w.x = cvt_pk_bf16(h0[0], h0[1]); w.y = cvt_pk_bf16(h0[2], h0[3]); w.z = cvt_pk_bf16(h1[0], h1[1]); w.w = cvt_pk_bf16(h1[2], h1[3]);
                *(u32x4*)(H + (size_t)(row0 + ai * HALF + m * 16) * 1024 + col0) = w;
            }
    }
};
struct EpiDown {
    static constexpr bool PERM = true, HAS_MID = false; static constexpr int MID_T = -1;
    const float *bd, *listw; const int* list; bf16_t* YB; MoeTabs T;
    __device__ __forceinline__ void mid(Acc&, const Unit&, int, int, int, int) const {}
    __device__ __forceinline__ void operator()(const Acc& acc, const Unit& u, int wr, int wc, int fr, int fq) const {
        const int e = T.tile_e[u.pm], p0 = (u.pm - T.tile0[e]) * BM + wr * 64 + fr, n = T.cnt[e], col0 = u.pn * BM + wc * 32 + 8 * fq;
        f32x4 b[2][2];
#pragma unroll
        for (int bj = 0; bj < 2; ++bj) { b[bj][0] = *(const f32x4*)(bd + e * 1024 + col0 + bj * HALF); b[bj][1] = *(const f32x4*)(bd + e * 1024 + col0 + bj * HALF + 4); }
#pragma unroll
        for (int ai = 0; ai < 2; ++ai)
#pragma unroll
            for (int m = 0; m < 4; ++m) {
                const int pos = p0 + ai * HALF + m * 16;
                if (pos < n) {
                    const int slot = list[(size_t)e * NTOK + pos]; const float w = listw[(size_t)e * NTOK + pos];
#pragma unroll
                    for (int bj = 0; bj < 2; ++bj) {
                        const f32x4 v0 = (acc[ai][bj][m][0] + b[bj][0]) * w, v1 = (acc[ai][bj][m][1] + b[bj][1]) * w;
                        u32x4 o; o.x = cvt_pk_bf16(v0[0], v0[1]); o.y = cvt_pk_bf16(v0[2], v0[3]); o.z = cvt_pk_bf16(v1[0], v1[1]); o.w = cvt_pk_bf16(v1[2], v1[3]);
                        *(u32x4*)(YB + (size_t)slot * 1024 + col0 + bj * HALF) = o;
                    }
                }
            }
    }
};
}

struct Args { const void* in[23]; float* out; unsigned char* ws; int ph_lo, ph_hi; };
struct Frame {
    LAS unsigned char* lds; int tid, lane, wave, vcu, G;
    const float *x, *c, *w_ada, *b_ada, *w_in, *pool_w, *pool_scale, *w_pool_out, *w_attn_out, *w_o, *ln1_g, *ln1_b, *w_router, *b_router;
    const float *w_gate, *b_gate, *w_up, *b_up, *w_down, *b_down, *ln2_g, *ln2_b; const int* positions;
    float* out; unsigned char* ws;
};
__device__ __forceinline__ float wsum(float v) {
#pragma unroll
    for (int o = 1; o < 64; o <<= 1) v += __shfl_xor(v, o);
    return v;
}
__device__ __forceinline__ unsigned pk2(float lo, float hi) { return (unsigned)f2bf(lo) | ((unsigned)f2bf(hi) << 16); }

__device__ __forceinline__ void p0_transpose_item(const float* W, int K, int N, bf16_t* WT, int dld, int koff, int mode, LAS float* scr, int item, int lane) {
    const int nblk = N / 32, kb = item / nblk, nb = item % nblk, k0 = 64 * kb, n0 = 32 * nb;
#pragma unroll 8
    for (int i = 0; i < 32; ++i) { const int kk = 2 * i + (lane >> 5); scr[kk * 33 + (lane & 31)] = W[(size_t)(k0 + kk) * N + n0 + (lane & 31)]; }
    LDS_WAIT(); asm volatile("" ::: "memory");
    const int c = lane & 7;
#pragma unroll
    for (int j = 0; j < 4; ++j) { const int n = (lane >> 3) + 8 * j; const LAS float* s = scr + (8 * c) * 33 + n;
        u32x4 o; o.x = pk2(s[0 * 33], s[1 * 33]); o.y = pk2(s[2 * 33], s[3 * 33]); o.z = pk2(s[4 * 33], s[5 * 33]); o.w = pk2(s[6 * 33], s[7 * 33]);
        *(GAS u32x4*)(WT + (size_t)rowmap(n0 + n, mode) * dld + koff + k0 + 8 * c) = o; }
    LDS_WAIT(); asm volatile("" ::: "memory");
}
__device__ __forceinline__ void p0_prologue(Frame& F) {
    unsigned char* ws = F.ws;
    bf16_t *wt_in = (bf16_t*)(ws + WS_WIN), *wt_pool = (bf16_t*)(ws + WS_WPOOL), *wt_cat = (bf16_t*)(ws + WS_WCAT), *wt_o = (bf16_t*)(ws + WS_WO), *wt_dn = (bf16_t*)(ws + WS_WDN), *wt_gu = (bf16_t*)(ws + WS_WGU);
    float* ada = (float*)(ws + WS_ADA); float* rope = (float*)(ws + WS_ROPE);
    for (int item = blockIdx.x; item < 256; item += F.G) {
        const int j0 = 24 * item;
        float a0[24], a1[24];
#pragma unroll
        for (int i = 0; i < 24; ++i) { a0[i] = 0.f; a1[i] = 0.f; }
#pragma unroll
        for (int kk = 0; kk < 2; ++kk) {
            const int k = 128 * F.wave + 2 * F.lane + kk;
            const float c0 = F.c[k], c1 = F.c[D + k]; const float s0 = c0 / (1.f + __expf(-c0)), s1 = c1 / (1.f + __expf(-c1));
            const f32x4* wp = (const f32x4*)(F.w_ada + (size_t)k * (6 * D) + j0);
#pragma unroll
            for (int i = 0; i < 6; ++i) { const f32x4 w = wp[i];
#pragma unroll
                for (int q = 0; q < 4; ++q) { a0[4 * i + q] += s0 * w[q]; a1[4 * i + q] += s1 * w[q]; } }
        }
        LAS float* red = (LAS float*)(F.lds);
#pragma unroll
        for (int i = 0; i < 24; ++i) { a0[i] = wsum(a0[i]); a1[i] = wsum(a1[i]); }
        if (F.lane == 0) {
#pragma unroll
            for (int i = 0; i < 24; ++i) { red[F.wave * 48 + i] = a0[i]; red[F.wave * 48 + 24 + i] = a1[i]; }
        }
        __syncthreads();
        if (F.tid < 48) { float s = 0.f;
#pragma unroll
            for (int w = 0; w < 8; ++w) s += red[w * 48 + F.tid];
            const int b = F.tid / 24, j = j0 + F.tid % 24; ada[b * 6 * D + j] = s + F.b_ada[j]; }
        __syncthreads();
    }
    for (int i = blockIdx.x * 512 + F.tid; i < NTOK * 8; i += F.G * 512) {
        const int tok = i >> 3, f = i & 7; const float ang = (float)F.positions[tok] * c_invfreq[f];
        rope[tok * 16 + f] = cosf(ang); rope[tok * 16 + 8 + f] = sinf(ang);
    }
    LAS float* scr = (LAS float*)(F.lds + F.wave * 16384);
    const int gw = F.vcu * NWAVES + F.wave, NGW = F.G * NWAVES;
    constexpr int I_IN = (D / 64) * (INW / 32), I_PW = 4 * 2 * 4, I_AO = (AOW / 64) * (D / 32), I_PO = (POOLW / 64) * (D / 32), I_O = (D / 64) * (D / 32), I_E = NE * I_O;
    constexpr int NITEMS = I_IN + I_PW + I_AO + I_PO + I_O + 3 * I_E;
    for (int it = gw; it < NITEMS; it += NGW) {
        int r = it;
        if (r < I_IN) { p0_transpose_item(F.w_in, D, INW, wt_in, D, 0, 0, scr, r, F.lane); continue; } r -= I_IN;
        if (r < I_PW) { const int g = r >> 3; p0_transpose_item(F.pool_w + g * 128 * 128, 128, 128, wt_pool + g * 128 * 128, 128, 0, 0, scr, r & 7, F.lane); continue; } r -= I_PW;
        if (r < I_AO) { p0_transpose_item(F.w_attn_out, AOW, D, wt_cat, 768, 0, 0, scr, r, F.lane); continue; } r -= I_AO;
        if (r < I_PO) { p0_transpose_item(F.w_pool_out, POOLW, D, wt_cat, 768, 256, 0, scr, r, F.lane); continue; } r -= I_PO;
        if (r < I_O) { p0_transpose_item(F.w_o, D, D, wt_o, D, 0, 0, scr, r, F.lane); continue; } r -= I_O;
        if (r < I_E) { const int e = r / I_O; p0_transpose_item(F.w_gate + (size_t)e * D * D, D, D, wt_gu + (size_t)e * 2048 * D, D, 0, 1, scr, r % I_O, F.lane); continue; } r -= I_E;
        if (r < I_E) { const int e = r / I_O; p0_transpose_item(F.w_up + (size_t)e * D * D, D, D, wt_gu + (size_t)e * 2048 * D, D, 0, 2, scr, r % I_O, F.lane); continue; } r -= I_E;
        { const int e = r / I_O; p0_transpose_item(F.w_down + (size_t)e * D * D, D, D, wt_dn + (size_t)e * D * D, D, 0, 0, scr, r % I_O, F.lane); }
    }
}
__device__ __forceinline__ void p1_lnmod(Frame& F) {
    const float* ada = (const float*)(F.ws + WS_ADA); bf16_t* U = (bf16_t*)(F.ws + WS_U);
    const int gw = F.vcu * NWAVES + F.wave, NGW = F.G * NWAVES;
    for (int row = gw; row < NTOK; row += NGW) {
        const GAS f32x4* xr = (const GAS f32x4*)(F.x + (size_t)row * D) + F.lane;
        f32x4 v[4]; float s = 0.f;
#pragma unroll
        for (int j = 0; j < 4; ++j) { v[j] = xr[64 * j]; s += (v[j].x + v[j].y) + (v[j].z + v[j].w); }
        const float mean = wsum(s) * (1.f / D); float s2 = 0.f;
#pragma unroll
        for (int j = 0; j < 4; ++j) { v[j] = v[j] - mean; s2 += (v[j].x * v[j].x + v[j].y * v[j].y) + (v[j].z * v[j].z + v[j].w * v[j].w); }
        const float rstd = rsqrtf(wsum(s2) * (1.f / D) + LN_EPS);
        const f32x4* sh = (const f32x4*)(ada + (row / S) * 6 * D) + F.lane; const f32x4* sc = (const f32x4*)(ada + (row / S) * 6 * D + D) + F.lane;
        GAS u32x2* o8 = (GAS u32x2*)(U + (size_t)row * D) + F.lane;
#pragma unroll
        for (int j = 0; j < 4; ++j) { const f32x4 y = v[j] * rstd * (sc[64 * j] + 1.0f) + sh[64 * j]; u32x2 w; w.x = cvt_pk_bf16(y.x, y.y); w.y = cvt_pk_bf16(y.z, y.w); o8[64 * j] = w; }
    }
}

__device__ __forceinline__ void glds16(const void* gsrc, unsigned lds_dst) { unsigned keep;
    asm volatile("s_mov_b32 %0, m0\n\ts_mov_b32 m0, %2\n\ts_nop 0\n\tglobal_load_lds_dwordx4 %1, off\n\ts_mov_b32 m0, %0" : "=&s"(keep) : "v"(gsrc), "s"(lds_dst) : "memory"); }
typedef short v4i16_t __attribute__((ext_vector_type(4)));
__device__ __forceinline__ s16x4 vtr(const LAS unsigned char* p) { return __builtin_bit_cast(s16x4, __builtin_amdgcn_ds_read_tr16_b64_v4i16((LAS v4i16_t*)p)); }

struct AttnDesc { int b, h, c, n, dl; };
__device__ __forceinline__ AttnDesc attn_decode(int uid) {
    AttnDesc d; d.b = uid / 768; const int rem = uid % 768; d.h = rem >> 6; const int x = rem & 63, g = d.h >> 2;
    d.dl = 1 << (2 * g); const int nb = 64 >> (2 * g); d.c = x / nb; d.n = x % nb; return d;
}
__device__ __forceinline__ void attn_issue(const Frame& F, int uid, int set) {
    const AttnDesc d = attn_decode(uid);
    const char* Qb = (const char*)(F.ws + WS_Q); const char* Kb = (const char*)(F.ws + WS_K); const char* Vb = (const char*)(F.ws + WS_V);
    const unsigned lds0 = (unsigned)(uintptr_t)F.lds, ldsK = lds0 + (unsigned)set * 65536u, ldsV = ldsK + 32768u;
    const int sub = F.lane >> 3, slot = F.lane & 7;
    const size_t hb = (size_t)d.h * 128;
#pragma unroll
    for (int pi = 0; pi < 4; ++pi) {
        const int p = 4 * F.wave + pi, key = 8 * p + sub, chunk = slot ^ (key & 7);
        const int jk = d.n > 0 ? 128 * (d.n - 1) + key : (key & 127);
        const size_t off = ((size_t)(d.b * S + d.c + d.dl * jk)) * (AW * 2) + hb + chunk * 16;
        glds16(Kb + off, (unsigned)__builtin_amdgcn_readfirstlane(ldsK + p * 1024));
        glds16(Vb + off, (unsigned)__builtin_amdgcn_readfirstlane(ldsV + p * 1024));
    }
#pragma unroll
    for (int qp = 0; qp < 2; ++qp) {
        const int qrow = 8 * qp + sub, chunk = slot ^ (qrow & 7);
        const size_t off = ((size_t)(d.b * S + d.c + d.dl * (128 * d.n + 16 * F.wave + qrow))) * (AW * 2) + hb + chunk * 16;
        glds16(Qb + off, (unsigned)__builtin_amdgcn_readfirstlane(lds0 + QREG_OFF + F.wave * 2048 + qp * 1024));
    }
}
__device__ __forceinline__ void attn_compute(const Frame& F, int uid, int set, bf16x8 qf0, bf16x8 qf1) {
    const AttnDesc d = attn_decode(uid);
    const int fr = F.lane & 15, fq = F.lane >> 4, w = F.wave;
    const unsigned ldsK = (unsigned)set * 65536u, ldsV = ldsK + 32768u;
    f32x4 st[9];
#pragma unroll
    for (int t = 0; t < 9; ++t) {
        const int key = 16 * (w + t) + fr;
        const LAS unsigned char* kp = F.lds + ldsK + key * 128;
        const bf16x8 k0 = *(const LAS bf16x8*)(kp + ((fq ^ (key & 7)) << 4)), k1 = *(const LAS bf16x8*)(kp + (((fq + 4) ^ (key & 7)) << 4));
        f32x4 a = {0.f, 0.f, 0.f, 0.f};
        a = __builtin_amdgcn_mfma_f32_16x16x32_bf16(k0, qf0, a, 0, 0, 0);
        a = __builtin_amdgcn_mfma_f32_16x16x32_bf16(k1, qf1, a, 0, 0, 0);
        st[t] = a;
    }
    const float NEG = -1e30f;
#pragma unroll
    for (int r = 0; r < 4; ++r) { if (4 * fq + r < fr) st[0][r] = NEG; if (4 * fq + r > fr) st[8][r] = NEG; }
    if (d.n == 0) {
#pragma unroll
        for (int t = 0; t < 8; ++t) if (w + t < 8) st[t] = (f32x4){NEG, NEG, NEG, NEG};
    }
    float m = NEG;
#pragma unroll
    for (int t = 0; t < 9; ++t) m = fmaxf(m, fmaxf(fmaxf(st[t][0], st[t][1]), fmaxf(st[t][2], st[t][3])));
    m = fmaxf(m, __shfl_xor(m, 16)); m = fmaxf(m, __shfl_xor(m, 32));
    float den = 0.f;
#pragma unroll
    for (int t = 0; t < 9; ++t) {
#pragma unroll
        for (int r = 0; r < 4; ++r) { const float p = __expf(st[t][r] - m); st[t][r] = p; den += p; }
    }
    den += __shfl_xor(den, 16); den += __shfl_xor(den, 32);
    f32x4 o[4];
#pragma unroll
    for (int dt = 0; dt < 4; ++dt) o[dt] = (f32x4){0.f, 0.f, 0.f, 0.f};
    const int q4 = fr >> 2, p4 = fr & 3;
#pragma unroll
    for (int j = 0; j < 5; ++j) {
        const int t0 = 2 * j, t1 = (2 * j + 1 < 9) ? 2 * j + 1 : 2 * j;
        bf16x8 pb;
        { const f32x4 sa = st[t0]; f32x4 sb = {0.f, 0.f, 0.f, 0.f}; if (2 * j + 1 < 9) sb = st[t1];
          const u32x4 pw = {cvt_pk_bf16(sa[0], sa[1]), cvt_pk_bf16(sa[2], sa[3]), cvt_pk_bf16(sb[0], sb[1]), cvt_pk_bf16(sb[2], sb[3])}; pb = __builtin_bit_cast(bf16x8, pw); }
        const int key0 = 16 * (w + t0) + 4 * fq + q4, key1 = 16 * (w + t1) + 4 * fq + q4;
#pragma unroll
        for (int dt = 0; dt < 4; ++dt) {
            const int ch = 2 * dt + (p4 >> 1);
            const s16x4 lo = vtr(F.lds + ldsV + key0 * 128 + ((ch ^ (key0 & 7)) << 4) + 8 * (p4 & 1));
            const s16x4 hi = vtr(F.lds + ldsV + key1 * 128 + ((ch ^ (key1 & 7)) << 4) + 8 * (p4 & 1));
            const bf16x8 va = {lo[0], lo[1], lo[2], lo[3], hi[0], hi[1], hi[2], hi[3]};
            o[dt] = __builtin_amdgcn_mfma_f32_16x16x32_bf16(va, pb, o[dt], 0, 0, 0);
        }
    }
    const float inv = 1.0f / den;
    const size_t tq = (size_t)(d.b * S + d.c + d.dl * (128 * d.n + 16 * w + fr));
    bf16_t* OG = (bf16_t*)(F.ws + WS_OG) + tq * AW + d.h * 64 + 4 * fq;
#pragma unroll
    for (int dt = 0; dt < 4; ++dt) { u32x2 wv; wv.x = cvt_pk_bf16(o[dt][0] * inv, o[dt][1] * inv); wv.y = cvt_pk_bf16(o[dt][2] * inv, o[dt][3] * inv); *(u32x2*)(OG + 16 * dt) = wv; }
    if (fq == 0) ((float*)(F.ws + WS_LSE))[tq * NH + d.h] = m + __logf(den);
}
__device__ __forceinline__ void p3_attention(Frame& F) {
    constexpr int NUNITS = NB * NH * 64;
    int i = 0, uid = F.vcu;
    if (uid < NUNITS) attn_issue(F, uid, 0);
    for (; uid < NUNITS; uid += F.G, ++i) {
        asm volatile("s_waitcnt vmcnt(0)" ::: "memory");
        __builtin_amdgcn_s_barrier();
        asm volatile("" ::: "memory");
        const int fr = F.lane & 15, fq = F.lane >> 4;
        const LAS unsigned char* qp = F.lds + QREG_OFF + F.wave * 2048 + fr * 128;
        const bf16x8 qf0 = *(const LAS bf16x8*)(qp + ((fq ^ (fr & 7)) << 4)), qf1 = *(const LAS bf16x8*)(qp + (((fq + 4) ^ (fr & 7)) << 4));
        asm volatile("s_waitcnt lgkmcnt(0)" ::: "memory");
        __builtin_amdgcn_sched_barrier(0);
        if (uid + F.G < NUNITS) attn_issue(F, uid + F.G, (i + 1) & 1);
        attn_compute(F, uid, i & 1, qf0, qf1);
    }
    asm volatile("s_waitcnt vmcnt(0)" ::: "memory");
    __builtin_amdgcn_s_barrier();
}
__device__ __forceinline__ void p3_pool(Frame& F) {
    const bf16_t* XP = (const bf16_t*)(F.ws + WS_XP); const bf16_t* WP = (const bf16_t*)(F.ws + WS_WPOOL); bf16_t* ACAT = (bf16_t*)(F.ws + WS_ACAT);
    const int gw = F.vcu * NWAVES + F.wave, NGW = F.G * NWAVES, fr = F.lane & 15, fq = F.lane >> 4;
    for (int wu = gw; wu < (NTOK / 16) * 4; wu += NGW) {
        const int g = wu & 3, tok = (wu >> 2) * 16 + fr, t = tok % S, W = 2 << g;
        const int cnt = (t + 1 < W) ? t + 1 : W; const float rc = 1.0f / (float)cnt;
        bf16x8 mb[4];
#pragma unroll
        for (int ks = 0; ks < 4; ++ks) {
            const bf16_t* base = XP + (size_t)tok * POOLW + g * 128 + 32 * ks + 8 * fq;
            const u32x4 self = *(const u32x4*)base;
            float s[8];
#pragma unroll
            for (int q = 0; q < 4; ++q) { s[2 * q] = bflo(self[q]); s[2 * q + 1] = bfhi(self[q]); }
            for (int j = 1; j < cnt; ++j) { const u32x4 pv = *(const u32x4*)(base - (size_t)j * POOLW);
#pragma unroll
                for (int q = 0; q < 4; ++q) { s[2 * q] += bflo(pv[q]); s[2 * q + 1] += bfhi(pv[q]); } }
            u32x4 mw;
#pragma unroll
            for (int q = 0; q < 4; ++q) mw[q] = cvt_pk_bf16(s[2 * q] * rc - bflo(self[q]), s[2 * q + 1] * rc - bfhi(self[q]));
            mb[ks] = __builtin_bit_cast(bf16x8, mw);
        }
#pragma unroll
        for (int nt = 0; nt < 8; ++nt) {
            f32x4 a = {0.f, 0.f, 0.f, 0.f};
#pragma unroll
            for (int ks = 0; ks < 4; ++ks) {
                const bf16x8 wa = *(const bf16x8*)(WP + (size_t)g * 128 * 128 + (size_t)(16 * nt + fr) * 128 + 32 * ks + 8 * fq);
                a = __builtin_amdgcn_mfma_f32_16x16x32_bf16(wa, mb[ks], a, 0, 0, 0);
            }
            const f32x4 sc = *(const f32x4*)(F.pool_scale + g * 128 + 16 * nt + 4 * fq);
            u32x2 wv; wv.x = cvt_pk_bf16(a[0] * sc[0], a[1] * sc[1]); wv.y = cvt_pk_bf16(a[2] * sc[2], a[3] * sc[3]);
            *(u32x2*)(ACAT + (size_t)tok * 768 + 256 + g * 128 + 16 * nt + 4 * fq) = wv;
        }
    }
}
__device__ __forceinline__ void p4_merge(Frame& F) {
    const bf16_t* OG = (const bf16_t*)(F.ws + WS_OG); const float* LSE = (const float*)(F.ws + WS_LSE); bf16_t* ACAT = (bf16_t*)(F.ws + WS_ACAT);
    for (int i = F.vcu * 512 + F.tid; i < NTOK * 32; i += F.G * 512) {
        const int ch = i & 7, hs = (i >> 3) & 3, tok = i >> 5;
        const float l0 = LSE[tok * NH + hs], l1 = LSE[tok * NH + 4 + hs], l2 = LSE[tok * NH + 8 + hs];
        const float mx = fmaxf(l0, fmaxf(l1, l2)); float w0 = __expf(l0 - mx), w1 = __expf(l1 - mx), w2 = __expf(l2 - mx); const float inv = 1.f / (w0 + w1 + w2);
        w0 *= inv; w1 *= inv; w2 *= inv;
        const bf16_t* p = OG + (size_t)tok * AW + hs * 64 + ch * 8;
        const u32x4 a = *(const u32x4*)p, b = *(const u32x4*)(p + 256), c = *(const u32x4*)(p + 512);
        u32x4 o;
#pragma unroll
        for (int q = 0; q < 4; ++q) o[q] = cvt_pk_bf16(w0 * bflo(a[q]) + w1 * bflo(b[q]) + w2 * bflo(c[q]), w0 * bfhi(a[q]) + w1 * bfhi(b[q]) + w2 * bfhi(c[q]));
        *(u32x4*)(ACAT + (size_t)tok * 768 + hs * 64 + ch * 8) = o;
    }
}
__device__ __forceinline__ void p7_router(Frame& F) {
    const float* ada = (const float*)(F.ws + WS_ADA); bf16_t* U2 = (bf16_t*)(F.ws + WS_U);
    int* cnt = (int*)(F.ws + WS_CTL) + CW_CNT; int* list = (int*)(F.ws + WS_LIST); float* listw = (float*)(F.ws + WS_LISTW);
    LAS int* lcnt = (LAS int*)(F.lds + TAB_OFF + T_LCNT); LAS int* gbase = (LAS int*)(F.lds + TAB_OFF + T_GBASE); LAS int* rec = (LAS int*)(F.lds + TAB_OFF + T_REC);
    LAS float* wscr = (LAS float*)(F.lds + TAB_OFF + T_WSCR + F.wave * 256);
    for (int i = F.tid; i < D * 8; i += 512) { const int c = i >> 3, s = i & 7; const f32x4 w = *(const f32x4*)(F.w_router + (size_t)c * NE + s * 4);
        *(LAS f32x4*)(F.lds + ((c & 3) * 256 + (c >> 2)) * 144 + s * 16) = w; }
    for (int tile = blockIdx.x; tile < NTOK / 64; tile += F.G) {
        if (F.tid < 32) lcnt[F.tid] = 0;
        __syncthreads();
        for (int rr = 0; rr < 8; ++rr) {
            const int rl = F.wave * 8 + rr, row = tile * 64 + rl, b = row / S;
            GAS f32x4* yr = (GAS f32x4*)(F.out + (size_t)row * D) + F.lane;
            f32x4 v[4]; float s = 0.f;
#pragma unroll
            for (int j = 0; j < 4; ++j) { v[j] = yr[64 * j]; s += (v[j].x + v[j].y) + (v[j].z + v[j].w); }
            float mean = wsum(s) * (1.f / D), s2 = 0.f;
#pragma unroll
            for (int j = 0; j < 4; ++j) { v[j] = v[j] - mean; s2 += (v[j].x * v[j].x + v[j].y * v[j].y) + (v[j].z * v[j].z + v[j].w * v[j].w); }
            float rstd = rsqrtf(wsum(s2) * (1.f / D) + LN_EPS);
            s = 0.f;
#pragma unroll
            for (int j = 0; j < 4; ++j) { const f32x4 g = ((const f32x4*)F.ln1_g)[F.lane + 64 * j], bb = ((const f32x4*)F.ln1_b)[F.lane + 64 * j];
                v[j] = v[j] * rstd * g + bb; yr[64 * j] = v[j]; s += (v[j].x + v[j].y) + (v[j].z + v[j].w); }
            mean = wsum(s) * (1.f / D); s2 = 0.f;
#pragma unroll
            for (int j = 0; j < 4; ++j) { v[j] = v[j] - mean; s2 += (v[j].x * v[j].x + v[j].y * v[j].y) + (v[j].z * v[j].z + v[j].w * v[j].w); }
            rstd = rsqrtf(wsum(s2) * (1.f / D) + LN_EPS);
            const f32x4* sh = (const f32x4*)(ada + b * 6 * D + 3 * D) + F.lane; const f32x4* sc = (const f32x4*)(ada + b * 6 * D + 4 * D) + F.lane;
            GAS u32x2* o8 = (GAS u32x2*)(U2 + (size_t)row * D) + F.lane;
#pragma unroll
            for (int j = 0; j < 4; ++j) { v[j] = v[j] * rstd * (sc[64 * j] + 1.0f) + sh[64 * j]; u32x2 w; w.x = cvt_pk_bf16(v[j].x, v[j].y); w.y = cvt_pk_bf16(v[j].z, v[j].w); o8[64 * j] = w; }
            float lg[NE];
#pragma unroll
            for (int e = 0; e < NE; ++e) lg[e] = 0.f;
#pragma unroll
            for (int j = 0; j < 4; ++j)
#pragma unroll
                for (int q = 0; q < 4; ++q) {
                    const LAS f32x4* wp = (const LAS f32x4*)(F.lds + (q * 256 + F.lane + 64 * j) * 144);
                    const float uv = v[j][q];
#pragma unroll
                    for (int s8 = 0; s8 < 8; ++s8) { const f32x4 w = wp[s8]; lg[4 * s8] += uv * w.x; lg[4 * s8 + 1] += uv * w.y; lg[4 * s8 + 2] += uv * w.z; lg[4 * s8 + 3] += uv * w.w; }
                }
            {
                float t16[16], t8[8], t4[4], t2[2], t1;
                const bool b5 = F.lane & 32, b4 = F.lane & 16, b3 = F.lane & 8, b2 = F.lane & 4, b1 = F.lane & 2;
#pragma unroll
                for (int k = 0; k < 16; ++k) { const float keep = b5 ? lg[k + 16] : lg[k], send = b5 ? lg[k] : lg[k + 16]; t16[k] = keep + __shfl_xor(send, 32); }
#pragma unroll
                for (int k = 0; k < 8; ++k) { const float keep = b4 ? t16[k + 8] : t16[k], send = b4 ? t16[k] : t16[k + 8]; t8[k] = keep + __shfl_xor(send, 16); }
#pragma unroll
                for (int k = 0; k < 4; ++k) { const float keep = b3 ? t8[k + 4] : t8[k], send = b3 ? t8[k] : t8[k + 4]; t4[k] = keep + __shfl_xor(send, 8); }
#pragma unroll
                for (int k = 0; k < 2; ++k) { const float keep = b2 ? t4[k + 2] : t4[k], send = b2 ? t4[k] : t4[k + 2]; t2[k] = keep + __shfl_xor(send, 4); }
                { const float keep = b1 ? t2[1] : t2[0], send = b1 ? t2[0] : t2[1]; t1 = keep + __shfl_xor(send, 2); }
                t1 += __shfl_xor(t1, 1);
                const int eidx = (b5 ? 16 : 0) + (b4 ? 8 : 0) + (b3 ? 4 : 0) + (b2 ? 2 : 0) + (b1 ? 1 : 0);
                if ((F.lane & 1) == 0) wscr[eidx] = t1 + F.b_router[eidx];
            }
            LDS_WAIT(); asm volatile("" ::: "memory");
            float lv[NE];
#pragma unroll
            for (int s8 = 0; s8 < 8; ++s8) { const f32x4 w = ((const LAS f32x4*)wscr)[s8]; lv[4 * s8] = w.x; lv[4 * s8 + 1] = w.y; lv[4 * s8 + 2] = w.z; lv[4 * s8 + 3] = w.w; }
            LDS_WAIT(); asm volatile("" ::: "memory");
            int idx[4]; float val[4]; unsigned used = 0u;
#pragma unroll
            for (int k = 0; k < 4; ++k) { int bi = 0; float bv = -3.4e38f;
#pragma unroll
                for (int e = 0; e < NE; ++e) { const bool take = !((used >> e) & 1u) && lv[e] > bv; bv = take ? lv[e] : bv; bi = take ? e : bi; }
                used |= 1u << bi; idx[k] = bi; val[k] = bv; }
            float pr[4], dsum = 0.f;
#pragma unroll
            for (int k = 0; k < 4; ++k) { pr[k] = __expf(val[k] - val[0]); dsum += pr[k]; }
            const float dinv = 1.f / dsum;
            if (F.lane < 4) {
                const int k = F.lane; const int e = k == 0 ? idx[0] : (k == 1 ? idx[1] : (k == 2 ? idx[2] : idx[3])); const float p = (k == 0 ? pr[0] : (k == 1 ? pr[1] : (k == 2 ? pr[2] : pr[3]))) * dinv;
                const int lp = __hip_atomic_fetch_add(lcnt + e, 1, __ATOMIC_RELAXED, __HIP_MEMORY_SCOPE_WORKGROUP);
                rec[(rl * 4 + k) * 3 + 0] = e; rec[(rl * 4 + k) * 3 + 1] = lp; rec[(rl * 4 + k) * 3 + 2] = (int)__float_as_uint(p);
            }
        }
        __syncthreads();
        if (F.tid < 32) gbase[F.tid] = (int)__hip_atomic_fetch_add((unsigned*)cnt + F.tid, (unsigned)lcnt[F.tid], __ATOMIC_RELAXED, __HIP_MEMORY_SCOPE_AGENT);
        __syncthreads();
        if (F.tid < 256) { const int e = rec[F.tid * 3], lp = rec[F.tid * 3 + 1]; const int pos = gbase[e] + lp;
            list[(size_t)e * NTOK + pos] = (tile * 64 + (F.tid >> 2)) * 4 + (F.tid & 3); listw[(size_t)e * NTOK + pos] = __uint_as_float((unsigned)rec[F.tid * 3 + 2]); }
        __syncthreads();
    }
}
__device__ __forceinline__ pg8::MoeTabs moe_tabs(Frame& F, int& ntiles) {
    const int* cnt = (const int*)(F.ws + WS_CTL) + CW_CNT;
    LAS int* tile_e = (LAS int*)(F.lds + TAB_OFF + T_TILE_E); LAS int* tile0 = (LAS int*)(F.lds + TAB_OFF + T_TILE0); LAS int* lc = (LAS int*)(F.lds + TAB_OFF + T_CNT); LAS int* lnt = (LAS int*)(F.lds + TAB_OFF + T_NT);
    __syncthreads();
    if (F.tid == 0) { int nt = 0;
        for (int e = 0; e < NE; ++e) { const int c = cnt[e]; lc[e] = c; tile0[e] = nt; const int t = (c + 255) >> 8; for (int i = 0; i < t; ++i) tile_e[nt + i] = e; nt += t; }
        tile0[NE] = nt; lnt[0] = nt; }
    __syncthreads();
    ntiles = lnt[0];
    pg8::MoeTabs T; T.tile_e = tile_e; T.tile0 = tile0; T.cnt = lc; return T;
}
__device__ __forceinline__ void p10_final(Frame& F) {
    const float* ada = (const float*)(F.ws + WS_ADA); const bf16_t* YB = (const bf16_t*)(F.ws + WS_YB);
    const int gw = F.vcu * NWAVES + F.wave, NGW = F.G * NWAVES;
    for (int row = gw; row < NTOK; row += NGW) {
        GAS f32x4* xr = (GAS f32x4*)(F.out + (size_t)row * D) + F.lane;
        const f32x4* gate = (const f32x4*)(ada + (row / S) * 6 * D + 5 * D) + F.lane;
        f32x4 v[4]; float s = 0.f;
#pragma unroll
        for (int j = 0; j < 4; ++j) {
            f32x4 f = {0.f, 0.f, 0.f, 0.f};
#pragma unroll
            for (int k = 0; k < 4; ++k) { const u32x2 y = *((const u32x2*)(YB + ((size_t)row * 4 + k) * D) + F.lane + 64 * j); f.x += bflo(y.x); f.y += bfhi(y.x); f.z += bflo(y.y); f.w += bfhi(y.y); }
            v[j] = xr[64 * j] * DN_ALPHA + (gate[64 * j] + 1.0f) * f; s += (v[j].x + v[j].y) + (v[j].z + v[j].w);
        }
        const float mean = wsum(s) * (1.f / D); float s2 = 0.f;
#pragma unroll
        for (int j = 0; j < 4; ++j) { v[j] = v[j] - mean; s2 += (v[j].x * v[j].x + v[j].y * v[j].y) + (v[j].z * v[j].z + v[j].w * v[j].w); }
        const float rstd = rsqrtf(wsum(s2) * (1.f / D) + LN_EPS);
#pragma unroll
        for (int j = 0; j < 4; ++j) xr[64 * j] = v[j] * rstd * ((const f32x4*)F.ln2_g)[F.lane + 64 * j] + ((const f32x4*)F.ln2_b)[F.lane + 64 * j];
    }
}

constexpr int NPHASES = 11;
constexpr int CW_BAR = 4096;
__global__ void __launch_bounds__(NWAVES * 64, 2) mk_fwd(Args args) {
    extern __shared__ __attribute__((aligned(16))) unsigned char lds_raw[];
    Frame F;
    F.lds = (LAS unsigned char*)lds_raw;
    F.tid = threadIdx.x; F.lane = F.tid & 63; F.wave = __builtin_amdgcn_readfirstlane(F.tid >> 6);
    F.G = gridDim.x; { const int bx = blockIdx.x; F.vcu = (F.G % 8 == 0) ? (bx % 8) * (F.G / 8) + bx / 8 : bx; }
    F.x = (const float*)args.in[0]; F.c = (const float*)args.in[1]; F.positions = (const int*)args.in[2]; F.w_ada = (const float*)args.in[3]; F.b_ada = (const float*)args.in[4];
    F.w_in = (const float*)args.in[5]; F.pool_w = (const float*)args.in[6]; F.pool_scale = (const float*)args.in[7]; F.w_pool_out = (const float*)args.in[8]; F.w_attn_out = (const float*)args.in[9];
    F.w_o = (const float*)args.in[10]; F.ln1_g = (const float*)args.in[11]; F.ln1_b = (const float*)args.in[12]; F.w_router = (const float*)args.in[13]; F.b_router = (const float*)args.in[14];
    F.w_gate = (const float*)args.in[15]; F.b_gate = (const float*)args.in[16]; F.w_up = (const float*)args.in[17]; F.b_up = (const float*)args.in[18]; F.w_down = (const float*)args.in[19];
    F.b_down = (const float*)args.in[20]; F.ln2_g = (const float*)args.in[21]; F.ln2_b = (const float*)args.in[22];
    F.out = args.out; F.ws = args.ws;
    unsigned char* ws = args.ws;
    volatile LAS unsigned* MISC = (volatile LAS unsigned*)(F.lds + TAB_OFF + T_MISC);
    if (F.tid < 32) MISC[F.tid] = 0u;
    __syncthreads();
    const int lo = args.ph_lo, hi = args.ph_hi;
    XcdBarrier bar; bar.bar = (unsigned*)(ws + WS_CTL) + CW_BAR; bar.x = 0; bar.st = nullptr;
    if (hi - lo > 1) bar = xcd_barrier_post((unsigned*)(ws + WS_CTL) + CW_BAR, MISC + 8);
#ifndef PH_EN
#define PH_EN 0x7ff
#endif
#define IN(k) (((PH_EN >> (k)) & 1) && lo <= (k) && (k) < hi)
#define BOTH(k) (IN(k) && IN((k) + 1))
#define GRID_BAR(k) do { if (BOTH(k)) xcd_barrier(bar); } while (0)
    bf16_t *U = (bf16_t*)(ws + WS_U), *ACAT = (bf16_t*)(ws + WS_ACAT), *H = (bf16_t*)(ws + WS_H), *YB = (bf16_t*)(ws + WS_YB);

    if (IN(0)) { p0_prologue(F); GRID_BAR(0); }
    if (IN(1)) { p1_lnmod(F); GRID_BAR(1); }
    if (IN(2)) {
        pg8::ProbDense<1024> P{U, (const bf16_t*)(ws + WS_WIN)}; pg8::StaticOrder S_; S_.init(NTOK, INW, F.G, (int)blockIdx.x);
        pg8::EpiProj E{(bf16_t*)(ws + WS_XP), (bf16_t*)(ws + WS_Q), (bf16_t*)(ws + WS_K), (bf16_t*)(ws + WS_V), (bf16_t*)(ws + WS_GP), (bf16_t*)(ws + WS_GA), (const float*)(ws + WS_ROPE)};
        pg8::gemm_phase<pg8::ProbDense<1024>, pg8::EpiProj, pg8::StaticOrder, true>(F.lds, P, S_, E);
        GRID_BAR(2);
    }
    if (IN(3)) { p3_attention(F); p3_pool(F); GRID_BAR(3); }
    if (IN(4)) { p4_merge(F); GRID_BAR(4); }
    if (IN(5)) {
        pg8::ProbDense<768> P{ACAT, (const bf16_t*)(ws + WS_WCAT)}; pg8::StaticOrder S_; S_.init(NTOK, D, F.G, (int)blockIdx.x);
        pg8::EpiMerged E{(const bf16_t*)(ws + WS_GP), (const bf16_t*)(ws + WS_GA), U};
        pg8::gemm_phase<pg8::ProbDense<768>, pg8::EpiMerged, pg8::StaticOrder, false>(F.lds, P, S_, E);
        GRID_BAR(5);
    }
    if (IN(6)) {
        pg8::ProbDense<1024> P{U, (const bf16_t*)(ws + WS_WO)}; pg8::StaticOrder S_; S_.init(NTOK, D, F.G, (int)blockIdx.x);
        pg8::EpiWo E{F.x, (const float*)(ws + WS_ADA), F.out};
        pg8::gemm_phase<pg8::ProbDense<1024>, pg8::EpiWo, pg8::StaticOrder, false>(F.lds, P, S_, E);
        GRID_BAR(6);
    }
    if (IN(7)) { p7_router(F); GRID_BAR(7); }
    if (IN(8)) {
        int ntiles; const pg8::MoeTabs T = moe_tabs(F, ntiles);
        pg8::ProbGU P{U, (const bf16_t*)(ws + WS_WGU), (const int*)(ws + WS_LIST), T}; pg8::MoeOrder S_; S_.init(ntiles, 8, F.G, (int)blockIdx.x);
        pg8::EpiGU E{F.b_gate, F.b_up, H, T};
        pg8::gemm_phase<pg8::ProbGU, pg8::EpiGU, pg8::MoeOrder, true>(F.lds, P, S_, E);
        GRID_BAR(8);
    }
    if (IN(9)) {
        int ntiles; const pg8::MoeTabs T = moe_tabs(F, ntiles);
        pg8::ProbDown P{H, (const bf16_t*)(ws + WS_WDN), T}; pg8::MoeOrder S_; S_.init(ntiles, 4, F.G, (int)blockIdx.x);
        pg8::EpiDown E{F.b_down, (const float*)(ws + WS_LISTW), (const int*)(ws + WS_LIST), YB, T};
        pg8::gemm_phase<pg8::ProbDown, pg8::EpiDown, pg8::MoeOrder, true>(F.lds, P, S_, E);
        GRID_BAR(9);
    }
    if (IN(10)) { p10_final(F); }
#undef IN
#undef BOTH
#undef GRID_BAR
}

#ifndef PMASK
#define PMASK 0x7ff
#endif
#ifndef ONE_LAUNCH
#define ONE_LAUNCH 1
#endif
extern "C" void kernel_launch(void* const* d_in, const int* in_sizes, int n_in, void* d_out, int out_size, void* d_ws, size_t ws_size, hipStream_t stream) {
    if (ws_size < WS_END || n_in < 23) { fprintf(stderr, "kernel_launch: workspace too small or wrong input count\n"); return; }
    static int grid = 0;
    if (grid == 0) {
        int dev = 0, cus = 0;
        if (hipGetDevice(&dev) != hipSuccess || hipDeviceGetAttribute(&cus, hipDeviceAttributeMultiprocessorCount, dev) != hipSuccess) { grid = -1; return; }
        if (hipFuncSetAttribute((const void*)mk_fwd, hipFuncAttributeMaxDynamicSharedMemorySize, LDS_BYTES) != hipSuccess) { fprintf(stderr, "kernel_launch: hipFuncSetAttribute failed\n"); grid = -1; return; }
        int per_cu = 0;
        if (hipOccupancyMaxActiveBlocksPerMultiprocessor(&per_cu, (const void*)mk_fwd, NWAVES * 64, LDS_BYTES) != hipSuccess || per_cu < 1) fprintf(stderr, "kernel_launch: occupancy query says %d\n", per_cu);
        (void)hipGetLastError();
        grid = cus;
    }
    if (grid < 0) return;
    const float* x = (const float*)d_in[0]; const float* c = (const float*)d_in[1]; const int* positions = (const int*)d_in[2];
    const float* w_ada = (const float*)d_in[3]; const float* b_ada = (const float*)d_in[4]; const float* w_in = (const float*)d_in[5];
    const float* pool_w = (const float*)d_in[6]; const float* pool_scale = (const float*)d_in[7]; const float* w_pool_out = (const float*)d_in[8];
    const float* w_attn_out = (const float*)d_in[9]; const float* w_o = (const float*)d_in[10]; const float* ln1_g = (const float*)d_in[11];
    const float* ln1_b = (const float*)d_in[12]; const float* w_router = (const float*)d_in[13]; const float* b_router = (const float*)d_in[14];
    const float* w_gate = (const float*)d_in[15]; const float* b_gate = (const float*)d_in[16]; const float* w_up = (const float*)d_in[17];
    const float* b_up = (const float*)d_in[18]; const float* w_down = (const float*)d_in[19]; const float* b_down = (const float*)d_in[20];
    const float* ln2_g = (const float*)d_in[21]; const float* ln2_b = (const float*)d_in[22];
    unsigned char* ws = (unsigned char*)d_ws; float* out = (float*)d_out;
    int* ctl = (int*)(ws + WS_CTL); float* ada = (float*)(ws + WS_ADA); float* rope = (float*)(ws + WS_ROPE);
    int* tok_e = (int*)(ws + WS_TOKE); float* tok_w = (float*)(ws + WS_TOKW); int* tok_p = (int*)(ws + WS_TOKP); int* meta = (int*)(ws + WS_META); int* list = (int*)(ws + WS_LIST); float* listw = (float*)(ws + WS_LISTW);
    bf16_t *wt_in = (bf16_t*)(ws + WS_WIN), *wt_pool = (bf16_t*)(ws + WS_WPOOL), *wt_cat = (bf16_t*)(ws + WS_WCAT), *wt_o = (bf16_t*)(ws + WS_WO), *wt_dn = (bf16_t*)(ws + WS_WDN), *wt_gu = (bf16_t*)(ws + WS_WGU);
    bf16_t *YB = (bf16_t*)(ws + WS_YB), *U = (bf16_t*)(ws + WS_U), *XP = (bf16_t*)(ws + WS_XP), *Q = (bf16_t*)(ws + WS_Q), *Kb = (bf16_t*)(ws + WS_K), *Vb = (bf16_t*)(ws + WS_V);
    bf16_t *GP = (bf16_t*)(ws + WS_GP), *GA = (bf16_t*)(ws + WS_GA), *H = (bf16_t*)(ws + WS_H), *ACAT = (bf16_t*)(ws + WS_ACAT), *OG = (bf16_t*)(ws + WS_OG), *MIX = (bf16_t*)(ws + WS_MIX);
    float* LSE = (float*)(ws + WS_LSE);
    int* cnt = ctl + CW_CNT;
    (void)hipMemsetAsync(ws + WS_CTL, 0, CTL_BYTES, stream);
    Args a{};
    for (int i = 0; i < 23; ++i) a.in[i] = d_in[i];
    a.out = out; a.ws = ws;
    if (ONE_LAUNCH && PMASK == 0x7ff) {
        a.ph_lo = 0; a.ph_hi = NPHASES;
        hipLaunchKernelGGL(mk_fwd, dim3(grid), dim3(NWAVES * 64), LDS_BYTES, stream, a);
        return;
    }
    for (int ph = 0; ph < NPHASES; ++ph) {
        if ((PMASK >> ph) & 1) { a.ph_lo = ph; a.ph_hi = ph + 1; hipLaunchKernelGGL(mk_fwd, dim3(grid), dim3(NWAVES * 64), LDS_BYTES, stream, a); continue; }
        switch (ph) {
        case 0:
            k_transpose<<<dim3(INW / 32, D / 32, 1), 256, 0, stream>>>(w_in, D, INW, 0, wt_in, D, 0, 0, 0);
            k_transpose<<<dim3(4, 4, 4), 256, 0, stream>>>(pool_w, 128, 128, 128 * 128, wt_pool, 128, 0, 128 * 128, 0);
            k_transpose<<<dim3(D / 32, AOW / 32, 1), 256, 0, stream>>>(w_attn_out, AOW, D, 0, wt_cat, 768, 0, 0, 0);
            k_transpose<<<dim3(D / 32, POOLW / 32, 1), 256, 0, stream>>>(w_pool_out, POOLW, D, 0, wt_cat, 768, 256, 0, 0);
            k_transpose<<<dim3(D / 32, D / 32, 1), 256, 0, stream>>>(w_o, D, D, 0, wt_o, D, 0, 0, 0);
            k_transpose<<<dim3(D / 32, D / 32, NE), 256, 0, stream>>>(w_gate, D, D, (size_t)D * D, wt_gu, D, 0, (size_t)2048 * D, 1);
            k_transpose<<<dim3(D / 32, D / 32, NE), 256, 0, stream>>>(w_up, D, D, (size_t)D * D, wt_gu, D, 0, (size_t)2048 * D, 2);
            k_transpose<<<dim3(D / 32, D / 32, NE), 256, 0, stream>>>(w_down, D, D, (size_t)D * D, wt_dn, D, 0, (size_t)D * D, 0);
            k_ada<<<dim3(6 * D / 256, NB), 256, 0, stream>>>(c, w_ada, b_ada, ada);
            k_rope<<<NTOK * 8 / 256, 256, 0, stream>>>(positions, rope);
            break;
        case 1: k_ln_mod<<<NTOK / 4, 256, 0, stream>>>(x, ada, 0, 1, U); break;
        case 2: { EpiProj e; memset(&e, 0, sizeof e); e.xp = XP; e.q = Q; e.k = Kb; e.v = Vb; e.gp = GP; e.ga = GA;
            k_gemm_naive<EpiProj, false, 0><<<dim3(INW / 64, NTOK / 64), 256, 0, stream>>>(U, D, wt_in, D, D, e);
            k_rotary<<<NTOK * NH * 8 / 256, 256, 0, stream>>>(Q, rope, 0.125f);
            k_scale_rest<<<NTOK * NH * 48 / 256, 256, 0, stream>>>(Q, 0.125f);
            k_rotary<<<NTOK * NH * 8 / 256, 256, 0, stream>>>(Kb, rope, 1.0f); } break;
        case 3:
            k_pool_mix<<<NTOK * POOLW / 256, 256, 0, stream>>>(XP, MIX);
            for (int g = 0; g < 4; ++g) { EpiPool e; memset(&e, 0, sizeof e); e.acat = ACAT; e.pscale = pool_scale; e.g = g;
                k_gemm_naive<EpiPool, false, 0><<<dim3(128 / 64, NTOK / 64), 256, 0, stream>>>(MIX + g * 128, POOLW, wt_pool + g * 128 * 128, 128, 128, e); }
            k_attn_naive<<<NTOK * NH / 256, 256, 0, stream>>>(Q, Kb, Vb, OG, LSE);
            break;
        case 4: k_merge<<<NTOK * AOW / 256, 256, 0, stream>>>(OG, LSE, ACAT); break;
        case 5: { EpiMerged e; memset(&e, 0, sizeof e); e.gp = GP; e.ga = GA; e.out = U;
            k_gemm_naive<EpiMerged, false, 256><<<dim3(D / 64, NTOK / 64), 256, 0, stream>>>(ACAT, 768, wt_cat, 768, 768, e); } break;
        case 6: { EpiWo e; memset(&e, 0, sizeof e); e.x = x; e.ada = ada; e.y = out;
            k_gemm_naive<EpiWo, false, 0><<<dim3(D / 64, NTOK / 64), 256, 0, stream>>>(U, D, wt_o, D, D, e); } break;
        case 7: k_ln1_router<<<NTOK / 4, 256, 0, stream>>>(out, ada, ln1_g, ln1_b, w_router, b_router, U, tok_e, tok_w, tok_p, list, listw, cnt); break;
        case 8: { k_moe_meta<<<1, 64, 0, stream>>>(cnt, meta);
            EpiGU e; memset(&e, 0, sizeof e); e.meta = meta; e.cnt = cnt; e.list = list; e.bg = b_gate; e.bu = b_up; e.H = H;
            k_gemm_naive<EpiGU, true, 0><<<dim3(D / 64, PMAX / 64), 256, 0, stream>>>(U, D, wt_gu, D, D, e); } break;
        case 9: { k_moe_meta<<<1, 64, 0, stream>>>(cnt, meta);
            EpiDown e; memset(&e, 0, sizeof e); e.meta = meta; e.cnt = cnt; e.list = list; e.bd = b_down; e.listw = listw; e.YB = YB;
            k_gemm_naive<EpiDown, false, 0><<<dim3(D / 64, PMAX / 64), 256, 0, stream>>>(H, D, wt_dn, D, D, e); } break;
        case 10: k_final<<<NTOK / 4, 256, 0, stream>>>(out, YB, ada, ln2_g, ln2_b); break;
        }
    }
}
```

```cpp
#include <hip/hip_runtime.h>
#include <stdint.h>
#include <stdio.h>
#include <string.h>

typedef unsigned short bf16_t;
typedef unsigned u32x4 __attribute__((ext_vector_type(4)));

constexpr int NB = 2, S = 8192, D = 1024, NTOK = NB * S;
constexpr int POOLW = 512, PGRP = 128;
constexpr int HD = 64, NH = 12, AW = 768, AOW = 256;
constexpr int INW = POOLW + 3 * AW + 2 * D;
constexpr int NE = 32, TOPK = 4, NASSIGN = NTOK * TOPK;
constexpr int MAXTILES = 288, PMAX = MAXTILES * 256;
constexpr float LN_EPS = 1e-5f;
constexpr float DN_ALPHA = 1.189207115002721f;
constexpr float SW_ALPHA = 1.702f, SW_LIMIT = 7.0f;

constexpr size_t MiB = 1u << 20;
constexpr size_t WS_CTL = 0, CTL_BYTES = 1 * MiB;
constexpr size_t WS_ADA = 1 * MiB;
constexpr size_t WS_ROPE = 2 * MiB;
constexpr size_t WS_LIST = 4 * MiB;
constexpr size_t WS_LISTW = 6 * MiB;
constexpr size_t WS_WIN = 8 * MiB;
constexpr size_t WS_WPOOL = 18 * MiB;
constexpr size_t WS_WCAT = 19 * MiB;
constexpr size_t WS_WO = 21 * MiB;
constexpr size_t WS_WDN = 24 * MiB;
constexpr size_t WS_WGU = 56 * MiB;
constexpr size_t WS_U = 120 * MiB;
constexpr size_t WS_U8 = 152 * MiB;
constexpr size_t WS_XP = 168 * MiB;
constexpr size_t WS_Q = 184 * MiB, WS_K = 208 * MiB, WS_V = 232 * MiB;
constexpr size_t WS_GP = 256 * MiB, WS_GA = 288 * MiB;
constexpr size_t WS_ACAT = 320 * MiB;
constexpr size_t WS_LSE = 344 * MiB;
constexpr size_t WS_OG = 346 * MiB;
constexpr size_t WS_H = 168 * MiB;
constexpr size_t WS_YB = 256 * MiB;
constexpr size_t WS_END = 384 * MiB;
constexpr int CW_CNT = 1024;
constexpr float SC_W = 256.f, SC_U = 8.f, SC_H = 8.f;

__device__ __forceinline__ float bf2f(bf16_t v) { return __uint_as_float((unsigned)v << 16); }
__device__ __forceinline__ bf16_t f2bf(float f) { unsigned u = __float_as_uint(f); return (bf16_t)((u + 0x7fffu + ((u >> 16) & 1u)) >> 16); }
__device__ __forceinline__ float sigmoidf_(float x) { return 1.0f / (1.0f + __expf(-x)); }
__device__ __forceinline__ float wave_sum(float v) {
#pragma unroll
    for (int o = 1; o < 64; o <<= 1) v += __shfl_xor(v, o);
    return v;
}

__device__ __forceinline__ int rowmap(int n, int mode) { return mode == 0 ? n : (256 * (n >> 7) + (n & 127) + (mode == 2 ? 128 : 0)); }
__constant__ float c_invfreq[8] = {1.0f, 0.1939227432012558f, 0.03760603070259094f, 0.007292664609849453f, 0.0014142135623842478f, 0.00027424818836152554f, 5.318296098266728e-05f, 1.0313386155758053e-05f};
#define LAS __attribute__((address_space(3)))
#define GAS __attribute__((address_space(1)))
typedef short bf16x8 __attribute__((ext_vector_type(8)));
typedef short s16x4 __attribute__((ext_vector_type(4)));
typedef float f32x4 __attribute__((ext_vector_type(4)));
typedef float f32x2 __attribute__((ext_vector_type(2)));
typedef unsigned u32x2 __attribute__((ext_vector_type(2)));
typedef GAS unsigned gu32;
#define RLX_AGENT __ATOMIC_RELAXED, __HIP_MEMORY_SCOPE_AGENT
#define LDS_WAIT() asm volatile("s_waitcnt lgkmcnt(0)" ::: "memory")
#define VM_WAIT() asm volatile("s_waitcnt vmcnt(0)" ::: "memory")

constexpr int NWAVES = 8;
constexpr int RING_BYTES = 131072;
constexpr int QREG_OFF = RING_BYTES;
constexpr int TAB_OFF = 147456;
constexpr int LDS_BYTES = 163840;
constexpr int T_MISC = 0;
constexpr int T_TILE_E = 256;
constexpr int T_TILE0 = 256 + 1280;
constexpr int T_CNT = T_TILE0 + 160;
constexpr int T_NT = T_CNT + 128;
constexpr int T_LCNT = T_NT + 16;
constexpr int T_GBASE = T_LCNT + 128;
constexpr int T_REC = T_GBASE + 128;
constexpr int T_WSCR = T_REC + 3072;
constexpr int T_END = T_WSCR + 2048;
static_assert(TAB_OFF + T_END <= LDS_BYTES, "LDS map");

__device__ __forceinline__ unsigned cvt_pk_bf16(float lo, float hi) { unsigned r; asm volatile("v_cvt_pk_bf16_f32 %0, %1, %2" : "=v"(r) : "v"(lo), "v"(hi)); return r; }
__device__ __forceinline__ float bflo(unsigned w) { return __uint_as_float(w << 16); }
__device__ __forceinline__ float bfhi(unsigned w) { return __uint_as_float(w & 0xffff0000u); }
__device__ __forceinline__ float fast_sigmoid(float x) { return __builtin_amdgcn_rcpf(1.0f + __expf(-x)); }

#ifndef SW_FP8
#define SW_FP8 0
#endif
__device__ __forceinline__ unsigned sw_e4m3(float x) {
    const unsigned u = __float_as_uint(x), s = (u >> 24) & 0x80u, ua = u & 0x7fffffffu; const float a = __uint_as_float(ua);
    unsigned m;
    if (a < 0.015625f) m = (unsigned)__float2int_rn(a * 512.0f);
    else { const unsigned r = ua + 0x7ffffu + ((ua >> 20) & 1u); m = (r >> 20) - (120u << 3); m = m > 0x7eu ? 0x7eu : m; }
    return s | m;
}
__device__ __forceinline__ int cvt4_fp8(float a, float b, float c, float d) {
    if (SW_FP8) return (int)(sw_e4m3(a) | (sw_e4m3(b) << 8) | (sw_e4m3(c) << 16) | (sw_e4m3(d) << 24));
    int w = __builtin_amdgcn_cvt_pk_fp8_f32(a, b, 0, false); return __builtin_amdgcn_cvt_pk_fp8_f32(c, d, w, true);
}
#define XB_TMO      128
#define XB_XCNT(j)  (256  + 64 * (j))
#define XB_XSUB(j)  (1280 + 64 * (j))
#define XB_XGEN(j)  (2304 + 64 * (j))
#define XB_TOP      3328
#define XB_TOPGEN   3392
#define XCD_BAR_WORDS 3456
#define XB_SPIN_CAP (1u << 18)
__device__ __forceinline__ unsigned xb_ld(unsigned* p)              { return __hip_atomic_load(p, __ATOMIC_RELAXED, __HIP_MEMORY_SCOPE_AGENT); }
__device__ __forceinline__ unsigned xb_add(unsigned* p, unsigned v) { return __hip_atomic_fetch_add(p, v, __ATOMIC_RELAXED, __HIP_MEMORY_SCOPE_AGENT); }
__device__ __forceinline__ unsigned xb_xcc_id() { return (unsigned)__builtin_amdgcn_s_getreg((3 << 11) | 20) & 0xFu; }
#define XB_SPIN(cond, bar) do { unsigned _sp = 0; while (cond) { __builtin_amdgcn_s_sleep(1); \
    if ((++_sp & 255u) == 0u) { if (xb_ld(&(bar)[XB_TMO])) break; if (_sp > XB_SPIN_CAP) { atomicAdd(&(bar)[XB_TMO], 1u); break; } } } } while (0)
struct XcdBarrier { unsigned* bar; unsigned x; volatile LAS unsigned* st; };
__device__ __forceinline__ XcdBarrier xcd_barrier_post(unsigned* bar, volatile LAS unsigned* st) {
    XcdBarrier b; b.bar = bar; b.x = xb_xcc_id(); b.st = st;
    if (threadIdx.x == 0) (void)xb_add(&bar[XB_XCNT(b.x)], 1u);
    return b;
}
__device__ __forceinline__ void xcd_barrier_complete(unsigned* bar, unsigned x, unsigned& nloc, unsigned& nx) {
    const unsigned G = gridDim.x * gridDim.y * gridDim.z;
    unsigned sum, cnt, mine, sp = 0u;
    for (;;) {
        sum = 0u; cnt = 0u; mine = 0u;
#pragma unroll
        for (unsigned j = 0; j < 16; ++j) { const unsigned c = xb_ld(&bar[XB_XCNT(j)]); sum += c; cnt += (c > 0u) ? 1u : 0u; mine = (j == x) ? c : mine; }
        if (sum == G) break;
        __builtin_amdgcn_s_sleep(1);
        if ((++sp & 255u) == 0u) { if (xb_ld(&bar[XB_TMO])) break; if (sp > XB_SPIN_CAP) { atomicAdd(&bar[XB_TMO], 1u); break; } }
    }
    nloc = mine > 0u ? mine : 1u; nx = cnt > 0u ? cnt : 1u;
}
__device__ __forceinline__ void xcd_barrier(const XcdBarrier& b) {
    asm volatile("s_waitcnt vmcnt(0)" ::: "memory");
    __syncthreads();
    if (threadIdx.x == 0) {
        unsigned* bar = b.bar;
        __builtin_amdgcn_s_waitcnt(0);
        unsigned nloc = b.st[0], nx = b.st[1];
        if (nloc == 0u) { xcd_barrier_complete(bar, b.x, nloc, nx); b.st[0] = nloc; b.st[1] = nx; }
        const unsigned old = xb_add(&bar[XB_XSUB(b.x)], 1u);
        const unsigned gen = old / nloc;
        if (old + 1u == (gen + 1u) * nloc) {
            __builtin_amdgcn_fence(__ATOMIC_RELEASE, "agent");
            asm volatile("s_waitcnt vmcnt(0)" ::: "memory");
            const unsigned og = xb_add(&bar[XB_TOP], 1u);
            const unsigned tg = og / nx;
            if (og + 1u == (tg + 1u) * nx) xb_add(&bar[XB_TOPGEN], 1u);
            else XB_SPIN(xb_ld(&bar[XB_TOPGEN]) == tg, bar);
            __builtin_amdgcn_fence(__ATOMIC_ACQUIRE, "agent");
            xb_add(&bar[XB_XGEN(b.x)], 1u);
            asm volatile("s_waitcnt vmcnt(0)" ::: "memory");
        } else {
            XB_SPIN(xb_ld(&bar[XB_XGEN(b.x)]) == gen, bar);
            __builtin_amdgcn_fence(__ATOMIC_ACQUIRE, "agent");
            asm volatile("s_waitcnt vmcnt(0)" ::: "memory");
        }
    }
    __syncthreads();
}

#ifndef FP8_PLAIN
#define FP8_PLAIN 0
#endif
namespace pg8 {
constexpr int BM = 256, BK = 64, HALF = 128, HTB = HALF * BK * 2, STAGE_BYTES = 8 * HTB, NXCD = 8, WGM = 8;
__host__ __device__ __forceinline__ int lds_byte(int r, int c) { const int st = (r >> 4) * 2 + (c >> 5), rr = r & 15, cc = c & 31, ob = rr * 64 + cc * 2; return st * 1024 + (ob ^ (((ob >> 9) & 1) << 5)); }
__host__ __device__ __forceinline__ void stage_rc(int b, int& R, int& C) { const int st = b / 1024, sb = b % 1024, swz = sb ^ (((sb >> 9) & 1) << 5); R = (st >> 1) * 16 + swz / 64; C = (st & 1) * 32 + (swz % 64) / 2; }
__host__ __device__ __forceinline__ int perm32(int rho) { const int n = rho >> 4, i = rho & 15; return 8 * (i >> 2) + 4 * n + (i & 3); }
struct Unit { int pm, pn; };
typedef int v8i32 __attribute__((ext_vector_type(8)));
typedef int v4i32 __attribute__((ext_vector_type(4)));
struct StaticOrder {
    int nM, nN, nwg, G, c;
    __device__ void init(int M, int N, int G_, int c_) { nM = M / BM; nN = N / BM; nwg = nM * nN; G = G_; c = c_; }
    __device__ bool next(int i, Unit& u) const {
        const long L = (long)i * G + c; if (L >= nwg) return false;
        int wgid = (int)L; { const int q = nwg / NXCD, r = nwg % NXCD, xcd = wgid % NXCD, off = wgid / NXCD; wgid = (xcd < r ? xcd * (q + 1) : r * (q + 1) + (xcd - r) * q) + off; }
        const int nig = WGM * nN, gid = wgid / nig, fm = gid * WGM, gsz = (nM - fm) < WGM ? (nM - fm) : WGM;
        u.pm = fm + ((wgid % nig) % gsz); u.pn = (wgid % nig) / gsz; return true;
    }
};
struct MoeOrder {
    int nN, nunits, G, c;
    __device__ void init(int ntiles, int nN_, int G_, int c_) { nN = nN_; nunits = ntiles * nN_; G = G_; c = c_; }
    __device__ bool next(int i, Unit& u) const { const int L = i * G + c; if (L >= nunits) return false; u.pm = L / nN; u.pn = L % nN; return true; }
};

template <class Prob, class Epi, class Sched, bool ALIGN_EPI, bool FP8 = false>
__device__ __forceinline__ void gemm_phase(LAS unsigned char* lds, const Prob& P, const Sched& S, const Epi& E) {
    const int tid = threadIdx.x, wid = __builtin_amdgcn_readfirstlane(tid >> 6), lane = tid & 63, wr = wid >> 2, wc = wid & 3, fr = lane & 15, fq = lane >> 4;
    constexpr int K = Prob::K, nt = K / BK;
    static_assert(nt % 2 == 0 && nt >= 4, "K must be a multiple of 128");
    unsigned voffB[2]; int sR[2], sC[2];
#pragma unroll
    for (int i = 0; i < 2; ++i) { int R, C; stage_rc(tid * 16 + i * 8192, R, C); const int Rb = Epi::PERM ? ((R & ~31) + perm32(R & 31)) : R;
        voffB[i] = (unsigned)(Rb * K + C) * 2u; sR[i] = R; sC[i] = C; }
    constexpr size_t kstep = (size_t)(BK * 2);
    constexpr size_t hstepB = (size_t)HALF * K * 2;
    const unsigned ldsw = (unsigned)wid * 1024u;
    const int aoff = lds_byte(wr * 64 + fr, fq * 8), boff = lds_byte(wc * 32 + fr, fq * 8);
#define PG8_SA(b, h) (((b) * 2 + (h)) * HTB)
#define PG8_SB(b, h) ((4 + (b) * 2 + (h)) * HTB)
#define PG8_STAGE(bufoff, gbase, voff) do { _Pragma("unroll") for (int _i = 0; _i < 2; ++_i) \
        __builtin_amdgcn_global_load_lds((const unsigned*)((const char*)(gbase) + (voff)[_i]), (LAS unsigned*)(lds + (bufoff) + ldsw + _i * 8192), 16, 0, 0); } while (0)
#define PG8_LDA(dst, b, h) do { _Pragma("unroll") for (int m = 0; m < 4; ++m) { dst[m].lo = *(const LAS v4i32*)(lds + PG8_SA(b, h) + aoff + m * 2048); dst[m].hi = *(const LAS v4i32*)(lds + PG8_SA(b, h) + aoff + m * 2048 + 1024); } } while (0)
#define PG8_LDB(dst, b, h) do { _Pragma("unroll") for (int n = 0; n < 2; ++n) { dst[n].lo = *(const LAS v4i32*)(lds + PG8_SB(b, h) + boff + n * 2048); dst[n].hi = *(const LAS v4i32*)(lds + PG8_SB(b, h) + boff + n * 2048 + 1024); } } while (0)
#define PG8_MMA(ai, bj, At, Bt) do { __builtin_amdgcn_s_setprio(1); _Pragma("unroll") for (int m = 0; m < 4; ++m) _Pragma("unroll") for (int n = 0; n < 2; ++n) { \
        if constexpr (FP8) { if constexpr (FP8_PLAIN) { _Pragma("unroll") for (int k4 = 0; k4 < 4; ++k4) { \
                const long bb = ((long)(unsigned)Bt[n][2 * k4 + 1] << 32) | (unsigned)Bt[n][2 * k4], aa = ((long)(unsigned)At[m][2 * k4 + 1] << 32) | (unsigned)At[m][2 * k4]; \
                acc[ai][bj][m][n] = __builtin_amdgcn_mfma_f32_16x16x32_fp8_fp8(bb, aa, acc[ai][bj][m][n], 0, 0, 0); } } \
            else acc[ai][bj][m][n] = __builtin_amdgcn_mfma_scale_f32_16x16x128_f8f6f4(Bt[n], At[m], acc[ai][bj][m][n], 0, 0, 0, Prob::SCALE_B, 0, Prob::SCALE_A); } \
        else { const v4i32 bl_ = Bt[n].lo, bh_ = Bt[n].hi, al_ = At[m].lo, ah_ = At[m].hi;     \
               acc[ai][bj][m][n] = __builtin_amdgcn_mfma_f32_16x16x32_bf16(__builtin_bit_cast(bf16x8, bl_), __builtin_bit_cast(bf16x8, al_), acc[ai][bj][m][n], 0, 0, 0); \
               acc[ai][bj][m][n] = __builtin_amdgcn_mfma_f32_16x16x32_bf16(__builtin_bit_cast(bf16x8, bh_), __builtin_bit_cast(bf16x8, ah_), acc[ai][bj][m][n], 0, 0, 0); } } \
        __builtin_amdgcn_s_setprio(0); } while (0)
#define PG8_WAIT_V(n) asm volatile("s_waitcnt vmcnt(" #n ")" ::: "memory")
#define PG8_WAIT_L(n) asm volatile("s_waitcnt lgkmcnt(" #n ")" ::: "memory")
#define PG8_BAR __builtin_amdgcn_s_barrier()
#define PG8_SCHED __builtin_amdgcn_sched_barrier(0)
#define PG8_SCHED8 do { if constexpr (FP8) __builtin_amdgcn_sched_barrier(0); } while (0)
#define PG8_PIN(ai) do { if constexpr (FP8) { _Pragma("unroll") for (int bj_ = 0; bj_ < 2; ++bj_) _Pragma("unroll") for (int m_ = 0; m_ < 4; ++m_) asm volatile("" : "+v"(acc[ai][bj_][m_][0]), "+v"(acc[ai][bj_][m_][1])); } } while (0)
    Unit cur, nxt; int ui = 0;
    if (!S.next(0, cur)) return;
    f32x4 acc[2][2][4][2];
#pragma unroll
    for (int a = 0; a < 2; ++a)
#pragma unroll
        for (int b = 0; b < 2; ++b)
#pragma unroll
            for (int m = 0; m < 4; ++m)
#pragma unroll
                for (int n = 0; n < 2; ++n) acc[a][b][m][n] = (f32x4){0.f, 0.f, 0.f, 0.f};
    v8i32 At[4], B0[2], B1[2];
    unsigned cv0[2], cv1[2], nv0[2], nv1[2];
    const char* cA = P.a_ptr(cur); const char* cB = P.b_ptr(cur);
    P.a_voff(cur, sR, sC, cv0, cv1);
    PG8_STAGE(PG8_SB(0, 0), cB, voffB); PG8_STAGE(PG8_SB(0, 1), cB + hstepB, voffB); PG8_STAGE(PG8_SA(0, 0), cA, cv0); PG8_STAGE(PG8_SA(0, 1), cA, cv1);
    if (wr == 1) PG8_BAR;
    PG8_WAIT_V(2); PG8_BAR;
    PG8_STAGE(PG8_SB(1, 0), cB + kstep, voffB); PG8_STAGE(PG8_SA(1, 0), cA + kstep, cv0); PG8_STAGE(PG8_SB(1, 1), cB + hstepB + kstep, voffB);
    PG8_WAIT_V(6); PG8_BAR;
    for (;;) {
        const bool has_next = S.next(ui + 1, nxt);
        const char* nA = has_next ? P.a_ptr(nxt) : cA; const char* nB = has_next ? P.b_ptr(nxt) : cB;
        if (has_next) P.a_voff(nxt, sR, sC, nv0, nv1); else { nv0[0] = cv0[0]; nv0[1] = cv0[1]; nv1[0] = cv1[0]; nv1[1] = cv1[1]; }
        for (int t = 0; t < nt; t += 2) {
            if constexpr (Epi::HAS_MID) { if (t == Epi::MID_T) E.mid(acc, cur, wr, wc, fr, fq); }
            const bool last = (t == nt - 2);
            const char* a1 = cA + (size_t)(t + 1) * kstep;
            const char* a2 = last ? nA : cA + (size_t)(t + 2) * kstep; const char* b2 = last ? nB : cB + (size_t)(t + 2) * kstep;
            const char* a3 = a2 + kstep; const char* b3 = b2 + kstep;
            unsigned v20[2], v21[2];
            v20[0] = last ? nv0[0] : cv0[0]; v20[1] = last ? nv0[1] : cv0[1]; v21[0] = last ? nv1[0] : cv1[0]; v21[1] = last ? nv1[1] : cv1[1];
            PG8_LDB(B0, 0, 0); PG8_LDB(B1, 0, 1); PG8_SCHED; PG8_LDA(At, 0, 0); PG8_STAGE(PG8_SA(1, 1), a1, cv1);
            PG8_WAIT_V(8); PG8_WAIT_L(0); PG8_BAR; PG8_SCHED8; PG8_MMA(0, 0, At, B0); PG8_MMA(0, 1, At, B1); PG8_PIN(0); PG8_SCHED8; PG8_BAR; PG8_SCHED;
            PG8_LDA(At, 0, 1); PG8_STAGE(PG8_SB(0, 0), b2, voffB); PG8_STAGE(PG8_SB(0, 1), b2 + hstepB, voffB); PG8_STAGE(PG8_SA(0, 0), a2, v20);
            PG8_WAIT_V(8); PG8_WAIT_L(0); PG8_BAR; PG8_SCHED8; PG8_MMA(1, 0, At, B0); PG8_MMA(1, 1, At, B1); PG8_PIN(1); PG8_SCHED8; PG8_BAR; PG8_SCHED;
            PG8_LDB(B0, 1, 0); PG8_LDB(B1, 1, 1); PG8_SCHED; PG8_LDA(At, 1, 0); PG8_STAGE(PG8_SA(0, 1), a2, v21);
            PG8_WAIT_V(8); PG8_WAIT_L(0); PG8_BAR; PG8_SCHED8; PG8_MMA(0, 0, At, B0); PG8_MMA(0, 1, At, B1); PG8_PIN(0); PG8_SCHED8; PG8_BAR; PG8_SCHED;
            PG8_LDA(At, 1, 1); PG8_STAGE(PG8_SB(1, 0), b3, voffB); PG8_STAGE(PG8_SB(1, 1), b3 + hstepB, voffB); PG8_STAGE(PG8_SA(1, 0), a3, v20);
            PG8_WAIT_V(8); PG8_WAIT_L(0); PG8_BAR; PG8_SCHED8; PG8_MMA(1, 0, At, B0); PG8_MMA(1, 1, At, B1); PG8_PIN(1); PG8_SCHED8; PG8_BAR; PG8_SCHED;
        }
        if constexpr (ALIGN_EPI) { if (wr == 0) PG8_BAR; }
        E(acc, cur, wr, wc, fr, fq);
        if (!has_next) break;
#pragma unroll
        for (int a = 0; a < 2; ++a)
#pragma unroll
            for (int b = 0; b < 2; ++b)
#pragma unroll
                for (int m = 0; m < 4; ++m)
#pragma unroll
                    for (int n = 0; n < 2; ++n) acc[a][b][m][n] = (f32x4){0.f, 0.f, 0.f, 0.f};
        cur = nxt; cA = nA; cB = nB; ++ui;
        cv0[0] = nv0[0]; cv0[1] = nv0[1]; cv1[0] = nv1[0]; cv1[1] = nv1[1];
        if constexpr (ALIGN_EPI) { if (wr == 1) PG8_BAR; }
    }
    PG8_WAIT_V(0);
    if constexpr (!ALIGN_EPI) { if (wr == 0) PG8_BAR; }
    PG8_BAR;
#undef PG8_SA
#undef PG8_SB
#undef PG8_STAGE
#undef PG8_LDA
#undef PG8_LDB
#undef PG8_MMA
#undef PG8_WAIT_V
#undef PG8_WAIT_L
#undef PG8_BAR
#undef PG8_SCHED
#undef PG8_SCHED8
#undef PG8_PIN
}

template <int K_> struct ProbDense {
    static constexpr int K = K_, SCALE_A = 0x7f7f7f7f, SCALE_B = 0x7f7f7f7f;
    const bf16_t* A; const bf16_t* Bt;
    __device__ __forceinline__ const char* a_ptr(const Unit& u) const { return (const char*)A + (size_t)u.pm * BM * K * 2; }
    __device__ __forceinline__ const char* b_ptr(const Unit& u) const { return (const char*)Bt + (size_t)u.pn * BM * K * 2; }
    __device__ __forceinline__ void a_voff(const Unit&, const int (&R)[2], const int (&C)[2], unsigned (&v0)[2], unsigned (&v1)[2]) const {
#pragma unroll
        for (int i = 0; i < 2; ++i) { v0[i] = (unsigned)(R[i] * K + C[i]) * 2u; v1[i] = (unsigned)((R[i] + HALF) * K + C[i]) * 2u; }
    }
};
struct MoeTabs { const LAS int* tile_e; const LAS int* tile0; const LAS int* cnt; };
struct ProbGU {
    static constexpr int K = 512, SCALE_A = 0x7c7c7c7c  , SCALE_B = 0x77777777  ;
    const bf16_t* U2; const bf16_t* W; const int* list; MoeTabs T;
    __device__ __forceinline__ const char* a_ptr(const Unit&) const { return (const char*)U2; }
    __device__ __forceinline__ const char* b_ptr(const Unit& u) const { const int e = T.tile_e[u.pm]; return (const char*)W + ((size_t)e * 2048 + (size_t)u.pn * BM) * K * 2; }
    __device__ __forceinline__ void a_voff(const Unit& u, const int (&R)[2], const int (&C)[2], unsigned (&v0)[2], unsigned (&v1)[2]) const {
        const int e = T.tile_e[u.pm], p0 = (u.pm - T.tile0[e]) * BM, n = T.cnt[e]; const int* L = list + (size_t)e * NTOK;
#pragma unroll
        for (int i = 0; i < 2; ++i) {
            const int pa = p0 + R[i], pb = p0 + R[i] + HALF;
            const int ta = pa < n ? (L[pa] >> 2) : 0, tb = pb < n ? (L[pb] >> 2) : 0;
            v0[i] = (unsigned)(ta * K + C[i]) * 2u; v1[i] = (unsigned)(tb * K + C[i]) * 2u;
        }
    }
};
struct ProbDown {
    static constexpr int K = 512, SCALE_A = 0x7c7c7c7c  , SCALE_B = 0x77777777  ;
    const bf16_t* H; const bf16_t* W; MoeTabs T;
    __device__ __forceinline__ const char* a_ptr(const Unit& u) const { return (const char*)H + (size_t)u.pm * BM * K * 2; }
    __device__ __forceinline__ const char* b_ptr(const Unit& u) const { const int e = T.tile_e[u.pm]; return (const char*)W + ((size_t)e * 1024 + (size_t)u.pn * BM) * K * 2; }
    __device__ __forceinline__ void a_voff(const Unit&, const int (&R)[2], const int (&C)[2], unsigned (&v0)[2], unsigned (&v1)[2]) const {
#pragma unroll
        for (int i = 0; i < 2; ++i) { v0[i] = (unsigned)(R[i] * K + C[i]) * 2u; v1[i] = (unsigned)((R[i] + HALF) * K + C[i]) * 2u; }
    }
};

typedef f32x4 Acc[2][2][4][2];
struct EpiProj {
    static constexpr bool PERM = true, HAS_MID = false; static constexpr int MID_T = -1;
    bf16_t *xp, *q, *k, *v, *gp, *ga; const float* rope;
    __device__ __forceinline__ void mid(Acc&, const Unit&, int, int, int, int) const {}
    __device__ __forceinline__ void operator()(const Acc& acc, const Unit& u, int wr, int wc, int fr, int fq) const {
        const int pn = u.pn; bf16_t* O; int ldc, ct; bool rot = false; float sc = 1.f;
        if (pn < 2) { O = xp; ldc = 512; ct = pn; } else if (pn < 5) { O = q; ldc = 768; ct = pn - 2; rot = true; sc = 0.125f; }
        else if (pn < 8) { O = k; ldc = 768; ct = pn - 5; rot = true; } else if (pn < 11) { O = v; ldc = 768; ct = pn - 8; }
        else if (pn < 15) { O = gp; ldc = 1024; ct = pn - 11; } else { O = ga; ldc = 1024; ct = pn - 15; }
        rot = rot && ((wc & 1) == 0);
        const int row0 = u.pm * BM + wr * 64 + fr, col0 = ct * BM + wc * 32 + 8 * fq;
        const float sgn = (fq == 0) ? -1.f : 1.f; const bool act = fq < 2;
#pragma unroll
        for (int ai = 0; ai < 2; ++ai)
#pragma unroll
            for (int m = 0; m < 4; ++m) {
                const int row = row0 + ai * HALF + m * 16;
                f32x4 c0 = {1.f, 1.f, 1.f, 1.f}, c1 = c0, s0 = {0.f, 0.f, 0.f, 0.f}, s1 = s0;
                if (rot) { const f32x4* rp = (const f32x4*)(rope + (size_t)row * 16); c0 = rp[0]; c1 = rp[1]; s0 = rp[2]; s1 = rp[3]; }
                bf16_t* rowp = O + (size_t)row * ldc + col0;
#pragma unroll
                for (int bj = 0; bj < 2; ++bj) {
                    f32x4 v0 = acc[ai][bj][m][0], v1 = acc[ai][bj][m][1];
                    if (rot) {
                        f32x4 p0, p1;
#pragma unroll
                        for (int j = 0; j < 4; ++j) { p0[j] = __shfl_xor(v0[j], 16); p1[j] = __shfl_xor(v1[j], 16); }
                        if (act) { v0 = v0 * c0 + (p0 * s0) * sgn; v1 = v1 * c1 + (p1 * s1) * sgn; }
                    }
                    v0 = v0 * sc; v1 = v1 * sc;
                    u32x4 w; w.x = cvt_pk_bf16(v0[0], v0[1]); w.y = cvt_pk_bf16(v0[2], v0[3]); w.z = cvt_pk_bf16(v1[0], v1[1]); w.w = cvt_pk_bf16(v1[2], v1[3]);
                    *(u32x4*)(rowp + bj * HALF) = w;
                }
            }
    }
};
struct EpiMerged {
    static constexpr bool PERM = true, HAS_MID = true; static constexpr int MID_T = 4;
    const bf16_t *gp, *ga; bf16_t* out;
    __device__ __forceinline__ void mid(Acc& acc, const Unit& u, int wr, int wc, int fr, int fq) const {
        int row0 = u.pm * BM + wr * 64 + fr; const int col0 = u.pn * BM + wc * 32 + 8 * fq;
        asm volatile("" : "+v"(row0));
#pragma unroll
        for (int ai = 0; ai < 2; ++ai)
#pragma unroll
            for (int m = 0; m < 4; ++m) {
                const size_t off = (size_t)(row0 + ai * HALF + m * 16) * D + col0;
#pragma unroll
                for (int bj = 0; bj < 2; ++bj) {
                    const u32x4 a = *(const u32x4*)(ga + off + bj * HALF), p = *(const u32x4*)(gp + off + bj * HALF);
                    f32x4 f0, f1;
#pragma unroll
                    for (int j = 0; j < 2; ++j) {
                        f0[2 * j] = fast_sigmoid(bflo(a[j])) * (1.f + __expf(-fmaxf(bflo(p[j]), -30.f)));
                        f0[2 * j + 1] = fast_sigmoid(bfhi(a[j])) * (1.f + __expf(-fmaxf(bfhi(p[j]), -30.f)));
                        f1[2 * j] = fast_sigmoid(bflo(a[2 + j])) * (1.f + __expf(-fmaxf(bflo(p[2 + j]), -30.f)));
                        f1[2 * j + 1] = fast_sigmoid(bfhi(a[2 + j])) * (1.f + __expf(-fmaxf(bfhi(p[2 + j]), -30.f)));
                    }
                    acc[ai][bj][m][0] *= f0; acc[ai][bj][m][1] *= f1;
                    asm volatile("" : "+v"(acc[ai][bj][m][0]), "+v"(acc[ai][bj][m][1]) :: "memory");
                }
            }
    }
    __device__ __forceinline__ void operator()(const Acc& acc, const Unit& u, int wr, int wc, int fr, int fq) const {
        const int row0 = u.pm * BM + wr * 64 + fr, col0 = u.pn * BM + wc * 32 + 8 * fq;
#pragma unroll
        for (int ai = 0; ai < 2; ++ai)
#pragma unroll
            for (int m = 0; m < 4; ++m) {
                const size_t off = (size_t)(row0 + ai * HALF + m * 16) * D + col0;
#pragma unroll
                for (int bj = 0; bj < 2; ++bj) {
                    const u32x4 p = *(const u32x4*)(gp + off + bj * HALF);
                    f32x4 v0 = acc[ai][bj][m][0], v1 = acc[ai][bj][m][1];
#pragma unroll
                    for (int j = 0; j < 2; ++j) {
                        v0[2 * j] *= fast_sigmoid(fmaxf(bflo(p[j]), -30.f)); v0[2 * j + 1] *= fast_sigmoid(fmaxf(bfhi(p[j]), -30.f));
                        v1[2 * j] *= fast_sigmoid(fmaxf(bflo(p[2 + j]), -30.f)); v1[2 * j + 1] *= fast_sigmoid(fmaxf(bfhi(p[2 + j]), -30.f));
                    }
                    u32x4 w; w.x = cvt_pk_bf16(v0[0], v0[1]); w.y = cvt_pk_bf16(v0[2], v0[3]); w.z = cvt_pk_bf16(v1[0], v1[1]); w.w = cvt_pk_bf16(v1[2], v1[3]);
                    *(u32x4*)(out + off + bj * HALF) = w;
                }
                asm volatile("" ::: "memory");
            }
    }
};
struct EpiWo {
    static constexpr bool PERM = false, HAS_MID = false; static constexpr int MID_T = -1;
    const float *x, *ada; float* y;
    __device__ __forceinline__ void mid(Acc&, const Unit&, int, int, int, int) const {}
    __device__ __forceinline__ void operator()(const Acc& acc, const Unit& u, int wr, int wc, int fr, int fq) const {
        const int row0 = u.pm * BM + wr * 64 + fr, col0 = u.pn * BM + wc * 32 + 4 * fq;
        const float* gate = ada + ((u.pm * BM) / S) * 6 * D + 2 * D;
        f32x4 gv[2][2];
#pragma unroll
        for (int bj = 0; bj < 2; ++bj)
#pragma unroll
            for (int n = 0; n < 2; ++n) gv[bj][n] = *(const f32x4*)(gate + col0 + bj * HALF + n * 16) + 1.0f;
#pragma unroll
        for (int ai = 0; ai < 2; ++ai)
#pragma unroll
            for (int m = 0; m < 4; ++m) {
                const size_t off = (size_t)(row0 + ai * HALF + m * 16) * D + col0;
#pragma unroll
                for (int bj = 0; bj < 2; ++bj)
#pragma unroll
                    for (int n = 0; n < 2; ++n) {
                        const f32x4 xv = *(const f32x4*)(x + off + bj * HALF + n * 16);
                        *(f32x4*)(y + off + bj * HALF + n * 16) = xv * DN_ALPHA + gv[bj][n] * acc[ai][bj][m][n];
                    }
            }
    }
};
struct EpiGU {
    static constexpr bool PERM = true, HAS_MID = false; static constexpr int MID_T = -1;
    const float *bg, *bu; bf16_t* H; MoeTabs T;
    __device__ __forceinline__ void mid(Acc&, const Unit&, int, int, int, int) const {}
    __device__ __forceinline__ void operator()(const Acc& acc, const Unit& u, int wr, int wc, int fr, int fq) const {
        const int e = T.tile_e[u.pm], col0 = u.pn * HALF + wc * 32 + 8 * fq, row0 = u.pm * BM + wr * 64 + fr;
        const float dsc = FP8_PLAIN ? (1.0f / 2048.0f) : 1.0f;
        const f32x4 bg0 = *(const f32x4*)(bg + e * 1024 + col0), bg1 = *(const f32x4*)(bg + e * 1024 + col0 + 4);
        const f32x4 bu0 = *(const f32x4*)(bu + e * 1024 + col0), bu1 = *(const f32x4*)(bu + e * 1024 + col0 + 4);
#pragma unroll
        for (int ai = 0; ai < 2; ++ai)
#pragma unroll
            for (int m = 0; m < 4; ++m) {
                f32x4 g0 = acc[ai][0][m][0] * dsc + bg0, g1 = acc[ai][0][m][1] * dsc + bg1, u0 = acc[ai][1][m][0] * dsc, u1 = acc[ai][1][m][1] * dsc;
                f32x4 h0, h1;
#pragma unroll
                for (int j = 0; j < 4; ++j) {
                    const float ga = fminf(g0[j], SW_LIMIT), gb = fminf(g1[j], SW_LIMIT);
                    const float ua = fminf(fmaxf(u0[j] + bu0[j], -SW_LIMIT), SW_LIMIT) + 1.0f, ub = fminf(fmaxf(u1[j] + bu1[j], -SW_LIMIT), SW_LIMIT) + 1.0f;
                    h0[j] = ga * fast_sigmoid(SW_ALPHA * ga) * ua; h1[j] = gb * fast_sigmoid(SW_ALPHA * gb) * ub;
                }
                h0 = h0 * SC_H; h1 = h1 * SC_H;
                u32x2 w; w.x = (unsigned)cvt4_fp8(h0[0], h0[1], h0[2], h0[3]); w.y = (unsigned)cvt4_fp8(h1[0], h1[1], h1[2], h1[3]);
                *(u32x2*)((unsigned char*)H + (size_t)(row0 + ai * HALF + m * 16) * 1024 + col0) = w;
            }
    }
};
struct EpiDown {
    static constexpr bool PERM = true, HAS_MID = false; static constexpr int MID_T = -1;
    const float *bd, *listw; const int* list; bf16_t* YB; MoeTabs T;
    __device__ __forceinline__ void mid(Acc&, const Unit&, int, int, int, int) const {}
    __device__ __forceinline__ void operator()(const Acc& acc, const Unit& u, int wr, int wc, int fr, int fq) const {
        const int e = T.tile_e[u.pm], p0 = (u.pm - T.tile0[e]) * BM + wr * 64 + fr, n = T.cnt[e], col0 = u.pn * BM + wc * 32 + 8 * fq;
        f32x4 b[2][2];
#pragma unroll
        for (int bj = 0; bj < 2; ++bj) { b[bj][0] = *(const f32x4*)(bd + e * 1024 + col0 + bj * HALF); b[bj][1] = *(const f32x4*)(bd + e * 1024 + col0 + bj * HALF + 4); }
#pragma unroll
        for (int ai = 0; ai < 2; ++ai)
#pragma unroll
            for (int m = 0; m < 4; ++m) {
                const int pos = p0 + ai * HALF + m * 16;
                if (pos < n) {
                    const int slot = list[(size_t)e * NTOK + pos]; const float w = listw[(size_t)e * NTOK + pos];
#pragma unroll
                    for (int bj = 0; bj < 2; ++bj) {
                        const float dsc = FP8_PLAIN ? (1.0f / 2048.0f) : 1.0f;
                        const f32x4 v0 = (acc[ai][bj][m][0] * dsc + b[bj][0]) * w, v1 = (acc[ai][bj][m][1] * dsc + b[bj][1]) * w;
                        u32x4 o; o.x = cvt_pk_bf16(v0[0], v0[1]); o.y = cvt_pk_bf16(v0[2], v0[3]); o.z = cvt_pk_bf16(v1[0], v1[1]); o.w = cvt_pk_bf16(v1[2], v1[3]);
                        *(u32x4*)(YB + (size_t)slot * 1024 + col0 + bj * HALF) = o;
                    }
                }
            }
    }
};
}

struct Args { const void* in[23]; float* out; unsigned char* ws; int ph_lo, ph_hi; };
struct Frame {
    LAS unsigned char* lds; int tid, lane, wave, vcu, G;
    const float *x, *c, *w_ada, *b_ada, *w_in, *pool_w, *pool_scale, *w_pool_out, *w_attn_out, *w_o, *ln1_g, *ln1_b, *w_router, *b_router;
    const float *w_gate, *b_gate, *w_up, *b_up, *w_down, *b_down, *ln2_g, *ln2_b; const int* positions;
    float* out; unsigned char* ws;
};
__device__ __forceinline__ float wsum(float v) {
#pragma unroll
    for (int o = 1; o < 64; o <<= 1) v += __shfl_xor(v, o);
    return v;
}
__device__ __forceinline__ unsigned pk2(float lo, float hi) { return (unsigned)f2bf(lo) | ((unsigned)f2bf(hi) << 16); }

__device__ __forceinline__ void p0_transpose_item(const float* W, int K, int N, bf16_t* WT, int dld, int koff, int mode, LAS float* scr, int item, int lane) {
    const int nblk = N / 32, kb = item / nblk, nb = item % nblk, k0 = 64 * kb, n0 = 32 * nb;
#pragma unroll 8
    for (int i = 0; i < 32; ++i) { const int kk = 2 * i + (lane >> 5); scr[kk * 33 + (lane & 31)] = W[(size_t)(k0 + kk) * N + n0 + (lane & 31)]; }
    LDS_WAIT(); asm volatile("" ::: "memory");
    const int c = lane & 7;
#pragma unroll
    for (int j = 0; j < 4; ++j) { const int n = (lane >> 3) + 8 * j; const LAS float* s = scr + (8 * c) * 33 + n;
        u32x4 o; o.x = pk2(s[0 * 33], s[1 * 33]); o.y = pk2(s[2 * 33], s[3 * 33]); o.z = pk2(s[4 * 33], s[5 * 33]); o.w = pk2(s[6 * 33], s[7 * 33]);
        *(GAS u32x4*)(WT + (size_t)rowmap(n0 + n, mode) * dld + koff + k0 + 8 * c) = o; }
    LDS_WAIT(); asm volatile("" ::: "memory");
}
__device__ __forceinline__ void p0_transpose_item_fp8(const float* W, int K, int N, unsigned char* WT, int mode, LAS float* scr, int item, int lane) {
    const int nblk = N / 32, kb = item / nblk, nb = item % nblk, k0 = 128 * kb, n0 = 32 * nb;
#pragma unroll 8
    for (int i = 0; i < 64; ++i) { const int kk = 2 * i + (lane >> 5); scr[kk * 33 + (lane & 31)] = W[(size_t)(k0 + kk) * N + n0 + (lane & 31)]; }
    LDS_WAIT(); asm volatile("" ::: "memory");
    const int c = lane & 7;
#pragma unroll
    for (int j = 0; j < 4; ++j) { const int n = (lane >> 3) + 8 * j; const LAS float* s = scr + (16 * c) * 33 + n;
        u32x4 o;
#pragma unroll
        for (int q = 0; q < 4; ++q) o[q] = (unsigned)cvt4_fp8(s[(4 * q) * 33] * SC_W, s[(4 * q + 1) * 33] * SC_W, s[(4 * q + 2) * 33] * SC_W, s[(4 * q + 3) * 33] * SC_W);
        *(GAS u32x4*)(WT + (size_t)rowmap(n0 + n, mode) * K + k0 + 16 * c) = o; }
    LDS_WAIT(); asm volatile("" ::: "memory");
}
__device__ __forceinline__ void p0_prologue(Frame& F) {
    unsigned char* ws = F.ws;
    bf16_t *wt_in = (bf16_t*)(ws + WS_WIN), *wt_pool = (bf16_t*)(ws + WS_WPOOL), *wt_cat = (bf16_t*)(ws + WS_WCAT), *wt_o = (bf16_t*)(ws + WS_WO), *wt_o2_unused = nullptr; unsigned char *wt_dn = ws + WS_WDN, *wt_gu = ws + WS_WGU; (void)wt_o2_unused;
    float* ada = (float*)(ws + WS_ADA); float* rope = (float*)(ws + WS_ROPE);
    for (int item = blockIdx.x; item < 256; item += F.G) {
        const int j0 = 24 * item;
        float a0[24], a1[24];
#pragma unroll
        for (int i = 0; i < 24; ++i) { a0[i] = 0.f; a1[i] = 0.f; }
#pragma unroll
        for (int kk = 0; kk < 2; ++kk) {
            const int k = 128 * F.wave + 2 * F.lane + kk;
            const float c0 = F.c[k], c1 = F.c[D + k]; const float s0 = c0 / (1.f + __expf(-c0)), s1 = c1 / (1.f + __expf(-c1));
            const f32x4* wp = (const f32x4*)(F.w_ada + (size_t)k * (6 * D) + j0);
#pragma unroll
            for (int i = 0; i < 6; ++i) { const f32x4 w = wp[i];
#pragma unroll
                for (int q = 0; q < 4; ++q) { a0[4 * i + q] += s0 * w[q]; a1[4 * i + q] += s1 * w[q]; } }
        }
        LAS float* red = (LAS float*)(F.lds);
#pragma unroll
        for (int i = 0; i < 24; ++i) { a0[i] = wsum(a0[i]); a1[i] = wsum(a1[i]); }
        if (F.lane == 0) {
#pragma unroll
            for (int i = 0; i < 24; ++i) { red[F.wave * 48 + i] = a0[i]; red[F.wave * 48 + 24 + i] = a1[i]; }
        }
        __syncthreads();
        if (F.tid < 48) { float s = 0.f;
#pragma unroll
            for (int w = 0; w < 8; ++w) s += red[w * 48 + F.tid];
            const int b = F.tid / 24, j = j0 + F.tid % 24; ada[b * 6 * D + j] = s + F.b_ada[j]; }
        __syncthreads();
    }
    for (int i = blockIdx.x * 512 + F.tid; i < NTOK * 8; i += F.G * 512) {
        const int tok = i >> 3, f = i & 7; const float ang = (float)F.positions[tok] * c_invfreq[f];
        rope[tok * 16 + f] = cosf(ang); rope[tok * 16 + 8 + f] = sinf(ang);
    }
    LAS float* scr = (LAS float*)(F.lds + F.wave * 16896);
    const int gw = F.vcu * NWAVES + F.wave, NGW = F.G * NWAVES;
    constexpr int I_IN = (D / 64) * (INW / 32), I_PW = 4 * 2 * 4, I_AO = (AOW / 64) * (D / 32), I_PO = (POOLW / 64) * (D / 32), I_O = (D / 64) * (D / 32), I_E8 = (D / 128) * (D / 32), I_E = NE * I_E8;
    constexpr int NITEMS = I_IN + I_PW + I_AO + I_PO + I_O + 3 * I_E;
    for (int it = gw; it < NITEMS; it += NGW) {
        int r = it;
        if (r < I_IN) { p0_transpose_item(F.w_in, D, INW, wt_in, D, 0, 0, scr, r, F.lane); continue; } r -= I_IN;
        if (r < I_PW) { const int g = r >> 3; p0_transpose_item(F.pool_w + g * 128 * 128, 128, 128, wt_pool + g * 128 * 128, 128, 0, 0, scr, r & 7, F.lane); continue; } r -= I_PW;
        if (r < I_AO) { p0_transpose_item(F.w_attn_out, AOW, D, wt_cat, 768, 0, 0, scr, r, F.lane); continue; } r -= I_AO;
        if (r < I_PO) { p0_transpose_item(F.w_pool_out, POOLW, D, wt_cat, 768, 256, 0, scr, r, F.lane); continue; } r -= I_PO;
        if (r < I_O) { p0_transpose_item(F.w_o, D, D, wt_o, D, 0, 0, scr, r, F.lane); continue; } r -= I_O;
        if (r < I_E) { const int e = r / I_E8; p0_transpose_item_fp8(F.w_gate + (size_t)e * D * D, D, D, wt_gu + (size_t)e * 2048 * D, 1, scr, r % I_E8, F.lane); continue; } r -= I_E;
        if (r < I_E) { const int e = r / I_E8; p0_transpose_item_fp8(F.w_up + (size_t)e * D * D, D, D, wt_gu + (size_t)e * 2048 * D, 2, scr, r % I_E8, F.lane); continue; } r -= I_E;
        { const int e = r / I_E8; p0_transpose_item_fp8(F.w_down + (size_t)e * D * D, D, D, wt_dn + (size_t)e * D * D, 0, scr, r % I_E8, F.lane); }
    }
}
__device__ __forceinline__ void p1_lnmod(Frame& F) {
    const float* ada = (const float*)(F.ws + WS_ADA); bf16_t* U = (bf16_t*)(F.ws + WS_U);
    const int gw = F.vcu * NWAVES + F.wave, NGW = F.G * NWAVES;
    for (int row = gw; row < NTOK; row += NGW) {
        const GAS f32x4* xr = (const GAS f32x4*)(F.x + (size_t)row * D) + F.lane;
        f32x4 v[4]; float s = 0.f;
#pragma unroll
        for (int j = 0; j < 4; ++j) { v[j] = xr[64 * j]; s += (v[j].x + v[j].y) + (v[j].z + v[j].w); }
        const float mean = wsum(s) * (1.f / D); float s2 = 0.f;
#pragma unroll
        for (int j = 0; j < 4; ++j) { v[j] = v[j] - mean; s2 += (v[j].x * v[j].x + v[j].y * v[j].y) + (v[j].z * v[j].z + v[j].w * v[j].w); }
        const float rstd = rsqrtf(wsum(s2) * (1.f / D) + LN_EPS);
        const f32x4* sh = (const f32x4*)(ada + (row / S) * 6 * D) + F.lane; const f32x4* sc = (const f32x4*)(ada + (row / S) * 6 * D + D) + F.lane;
        GAS u32x2* o8 = (GAS u32x2*)(U + (size_t)row * D) + F.lane;
#pragma unroll
        for (int j = 0; j < 4; ++j) { const f32x4 y = v[j] * rstd * (sc[64 * j] + 1.0f) + sh[64 * j]; u32x2 w; w.x = cvt_pk_bf16(y.x, y.y); w.y = cvt_pk_bf16(y.z, y.w); o8[64 * j] = w; }
    }
}

__device__ __forceinline__ void glds16(const void* gsrc, unsigned lds_dst) { unsigned keep;
    asm volatile("s_mov_b32 %0, m0\n\ts_mov_b32 m0, %2\n\ts_nop 0\n\tglobal_load_lds_dwordx4 %1, off\n\ts_mov_b32 m0, %0" : "=&s"(keep) : "v"(gsrc), "s"(lds_dst) : "memory"); }
typedef short v4i16_t __attribute__((ext_vector_type(4)));
__device__ __forceinline__ s16x4 vtr(const LAS unsigned char* p) { return __builtin_bit_cast(s16x4, __builtin_amdgcn_ds_read_tr16_b64_v4i16((LAS v4i16_t*)p)); }

struct AttnDesc { int b, h, c, n, dl; };
__device__ __forceinline__ AttnDesc attn_decode(int uid) {
    AttnDesc d; d.b = uid / 768; const int rem = uid % 768; d.h = rem >> 6; const int x = rem & 63, g = d.h >> 2;
    d.dl = 1 << (2 * g); const int nb = 64 >> (2 * g); d.c = x / nb; d.n = x % nb; return d;
}
__device__ __forceinline__ void attn_issue(const Frame& F, int uid, int set) {
    const AttnDesc d = attn_decode(uid);
    const char* Qb = (const char*)(F.ws + WS_Q); const char* Kb = (const char*)(F.ws + WS_K); const char* Vb = (const char*)(F.ws + WS_V);
    const unsigned lds0 = (unsigned)(uintptr_t)F.lds, ldsK = lds0 + (unsigned)set * 65536u, ldsV = ldsK + 32768u;
    const int sub = F.lane >> 3, slot = F.lane & 7;
    const size_t hb = (size_t)d.h * 128;
#pragma unroll
    for (int pi = 0; pi < 4; ++pi) {
        const int p = 4 * F.wave + pi, key = 8 * p + sub, chunk = slot ^ (key & 7);
        const int jk = d.n > 0 ? 128 * (d.n - 1) + key : (key & 127);
        const size_t off = ((size_t)(d.b * S + d.c + d.dl * jk)) * (AW * 2) + hb + chunk * 16;
        glds16(Kb + off, (unsigned)__builtin_amdgcn_readfirstlane(ldsK + p * 1024));
        glds16(Vb + off, (unsigned)__builtin_amdgcn_readfirstlane(ldsV + p * 1024));
    }
#pragma unroll
    for (int qp = 0; qp < 2; ++qp) {
        const int qrow = 8 * qp + sub, chunk = slot ^ (qrow & 7);
        const size_t off = ((size_t)(d.b * S + d.c + d.dl * (128 * d.n + 16 * F.wave + qrow))) * (AW * 2) + hb + chunk * 16;
        glds16(Qb + off, (unsigned)__builtin_amdgcn_readfirstlane(lds0 + QREG_OFF + F.wave * 2048 + qp * 1024));
    }
}
__device__ __forceinline__ void attn_compute(const Frame& F, int uid, int set, bf16x8 qf0, bf16x8 qf1) {
    const AttnDesc d = attn_decode(uid);
    const int fr = F.lane & 15, fq = F.lane >> 4, w = F.wave;
    const unsigned ldsK = (unsigned)set * 65536u, ldsV = ldsK + 32768u;
    f32x4 st[9];
#pragma unroll
    for (int t = 0; t < 9; ++t) {
        const int key = 16 * (w + t) + fr;
        const LAS unsigned char* kp = F.lds + ldsK + key * 128;
        const bf16x8 k0 = *(const LAS bf16x8*)(kp + ((fq ^ (key & 7)) << 4)), k1 = *(const LAS bf16x8*)(kp + (((fq + 4) ^ (key & 7)) << 4));
        f32x4 a = {0.f, 0.f, 0.f, 0.f};
        a = __builtin_amdgcn_mfma_f32_16x16x32_bf16(k0, qf0, a, 0, 0, 0);
        a = __builtin_amdgcn_mfma_f32_16x16x32_bf16(k1, qf1, a, 0, 0, 0);
        st[t] = a;
    }
    const float NEG = -1e30f;
#pragma unroll
    for (int r = 0; r < 4; ++r) { if (4 * fq + r < fr) st[0][r] = NEG; if (4 * fq + r > fr) st[8][r] = NEG; }
    if (d.n == 0) {
#pragma unroll
        for (int t = 0; t < 8; ++t) if (w + t < 8) st[t] = (f32x4){NEG, NEG, NEG, NEG};
    }
    float m = NEG;
#pragma unroll
    for (int t = 0; t < 9; ++t) m = fmaxf(m, fmaxf(fmaxf(st[t][0], st[t][1]), fmaxf(st[t][2], st[t][3])));
    m = fmaxf(m, __shfl_xor(m, 16)); m = fmaxf(m, __shfl_xor(m, 32));
    float den = 0.f;
#pragma unroll
    for (int t = 0; t < 9; ++t) {
#pragma unroll
        for (int r = 0; r < 4; ++r) { const float p = __expf(st[t][r] - m); st[t][r] = p; den += p; }
    }
    den += __shfl_xor(den, 16); den += __shfl_xor(den, 32);
    f32x4 o[4];
#pragma unroll
    for (int dt = 0; dt < 4; ++dt) o[dt] = (f32x4){0.f, 0.f, 0.f, 0.f};
    const int q4 = fr >> 2, p4 = fr & 3;
#pragma unroll
    for (int j = 0; j < 5; ++j) {
        const int t0 = 2 * j, t1 = (2 * j + 1 < 9) ? 2 * j + 1 : 2 * j;
        bf16x8 pb;
        { const f32x4 sa = st[t0]; f32x4 sb = {0.f, 0.f, 0.f, 0.f}; if (2 * j + 1 < 9) sb = st[t1];
          const u32x4 pw = {cvt_pk_bf16(sa[0], sa[1]), cvt_pk_bf16(sa[2], sa[3]), cvt_pk_bf16(sb[0], sb[1]), cvt_pk_bf16(sb[2], sb[3])}; pb = __builtin_bit_cast(bf16x8, pw); }
        const int key0 = 16 * (w + t0) + 4 * fq + q4, key1 = 16 * (w + t1) + 4 * fq + q4;
#pragma unroll
        for (int dt = 0; dt < 4; ++dt) {
            const int ch = 2 * dt + (p4 >> 1);
            const s16x4 lo = vtr(F.lds + ldsV + key0 * 128 + ((ch ^ (key0 & 7)) << 4) + 8 * (p4 & 1));
            const s16x4 hi = vtr(F.lds + ldsV + key1 * 128 + ((ch ^ (key1 & 7)) << 4) + 8 * (p4 & 1));
            const bf16x8 va = {lo[0], lo[1], lo[2], lo[3], hi[0], hi[1], hi[2], hi[3]};
            o[dt] = __builtin_amdgcn_mfma_f32_16x16x32_bf16(va, pb, o[dt], 0, 0, 0);
        }
    }
    const float inv = 1.0f / den;
    const size_t tq = (size_t)(d.b * S + d.c + d.dl * (128 * d.n + 16 * w + fr));
    bf16_t* OG = (bf16_t*)(F.ws + WS_OG) + tq * AW + d.h * 64 + 4 * fq;
#pragma unroll
    for (int dt = 0; dt < 4; ++dt) { u32x2 wv; wv.x = cvt_pk_bf16(o[dt][0] * inv, o[dt][1] * inv); wv.y = cvt_pk_bf16(o[dt][2] * inv, o[dt][3] * inv); *(u32x2*)(OG + 16 * dt) = wv; }
    if (fq == 0) ((float*)(F.ws + WS_LSE))[tq * NH + d.h] = m + __logf(den);
}
__device__ __forceinline__ void p3_attention(Frame& F) {
    constexpr int NUNITS = NB * NH * 64;
    int i = 0, uid = F.vcu;
    if (uid < NUNITS) attn_issue(F, uid, 0);
    for (; uid < NUNITS; uid += F.G, ++i) {
        asm volatile("s_waitcnt vmcnt(0)" ::: "memory");
        __builtin_amdgcn_s_barrier();
        asm volatile("" ::: "memory");
        const int fr = F.lane & 15, fq = F.lane >> 4;
        const LAS unsigned char* qp = F.lds + QREG_OFF + F.wave * 2048 + fr * 128;
        const bf16x8 qf0 = *(const LAS bf16x8*)(qp + ((fq ^ (fr & 7)) << 4)), qf1 = *(const LAS bf16x8*)(qp + (((fq + 4) ^ (fr & 7)) << 4));
        asm volatile("s_waitcnt lgkmcnt(0)" ::: "memory");
        __builtin_amdgcn_sched_barrier(0);
        if (uid + F.G < NUNITS) attn_issue(F, uid + F.G, (i + 1) & 1);
        attn_compute(F, uid, i & 1, qf0, qf1);
    }
    asm volatile("s_waitcnt vmcnt(0)" ::: "memory");
    __builtin_amdgcn_s_barrier();
}
__device__ __forceinline__ void p3_pool(Frame& F) {
    const bf16_t* XP = (const bf16_t*)(F.ws + WS_XP); const bf16_t* WP = (const bf16_t*)(F.ws + WS_WPOOL); bf16_t* ACAT = (bf16_t*)(F.ws + WS_ACAT);
    const int gw = F.vcu * NWAVES + F.wave, NGW = F.G * NWAVES, fr = F.lane & 15, fq = F.lane >> 4;
    for (int wu = gw; wu < (NTOK / 16) * 4; wu += NGW) {
        const int g = wu & 3, tok = (wu >> 2) * 16 + fr, t = tok % S, W = 2 << g;
        const int cnt = (t + 1 < W) ? t + 1 : W; const float rc = 1.0f / (float)cnt;
        bf16x8 mb[4];
#pragma unroll
        for (int ks = 0; ks < 4; ++ks) {
            const bf16_t* base = XP + (size_t)tok * POOLW + g * 128 + 32 * ks + 8 * fq;
            const u32x4 self = *(const u32x4*)base;
            float s[8];
#pragma unroll
            for (int q = 0; q < 4; ++q) { s[2 * q] = bflo(self[q]); s[2 * q + 1] = bfhi(self[q]); }
            for (int j = 1; j < cnt; ++j) { const u32x4 pv = *(const u32x4*)(base - (size_t)j * POOLW);
#pragma unroll
                for (int q = 0; q < 4; ++q) { s[2 * q] += bflo(pv[q]); s[2 * q + 1] += bfhi(pv[q]); } }
            u32x4 mw;
#pragma unroll
            for (int q = 0; q < 4; ++q) mw[q] = cvt_pk_bf16(s[2 * q] * rc - bflo(self[q]), s[2 * q + 1] * rc - bfhi(self[q]));
            mb[ks] = __builtin_bit_cast(bf16x8, mw);
        }
#pragma unroll
        for (int nt = 0; nt < 8; ++nt) {
            f32x4 a = {0.f, 0.f, 0.f, 0.f};
#pragma unroll
            for (int ks = 0; ks < 4; ++ks) {
                const bf16x8 wa = *(const bf16x8*)(WP + (size_t)g * 128 * 128 + (size_t)(16 * nt + fr) * 128 + 32 * ks + 8 * fq);
                a = __builtin_amdgcn_mfma_f32_16x16x32_bf16(wa, mb[ks], a, 0, 0, 0);
            }
            const f32x4 sc = *(const f32x4*)(F.pool_scale + g * 128 + 16 * nt + 4 * fq);
            u32x2 wv; wv.x = cvt_pk_bf16(a[0] * sc[0], a[1] * sc[1]); wv.y = cvt_pk_bf16(a[2] * sc[2], a[3] * sc[3]);
            *(u32x2*)(ACAT + (size_t)tok * 768 + 256 + g * 128 + 16 * nt + 4 * fq) = wv;
        }
    }
}
__device__ __forceinline__ void p4_merge(Frame& F) {
    const bf16_t* OG = (const bf16_t*)(F.ws + WS_OG); const float* LSE = (const float*)(F.ws + WS_LSE); bf16_t* ACAT = (bf16_t*)(F.ws + WS_ACAT);
    for (int i = F.vcu * 512 + F.tid; i < NTOK * 32; i += F.G * 512) {
        const int ch = i & 7, hs = (i >> 3) & 3, tok = i >> 5;
        const float l0 = LSE[tok * NH + hs], l1 = LSE[tok * NH + 4 + hs], l2 = LSE[tok * NH + 8 + hs];
        const float mx = fmaxf(l0, fmaxf(l1, l2)); float w0 = __expf(l0 - mx), w1 = __expf(l1 - mx), w2 = __expf(l2 - mx); const float inv = 1.f / (w0 + w1 + w2);
        w0 *= inv; w1 *= inv; w2 *= inv;
        const bf16_t* p = OG + (size_t)tok * AW + hs * 64 + ch * 8;
        const u32x4 a = *(const u32x4*)p, b = *(const u32x4*)(p + 256), c = *(const u32x4*)(p + 512);
        u32x4 o;
#pragma unroll
        for (int q = 0; q < 4; ++q) o[q] = cvt_pk_bf16(w0 * bflo(a[q]) + w1 * bflo(b[q]) + w2 * bflo(c[q]), w0 * bfhi(a[q]) + w1 * bfhi(b[q]) + w2 * bfhi(c[q]));
        *(u32x4*)(ACAT + (size_t)tok * 768 + hs * 64 + ch * 8) = o;
    }
}
__device__ __forceinline__ void p7_router(Frame& F) {
    const float* ada = (const float*)(F.ws + WS_ADA); unsigned char* U8 = F.ws + WS_U8;
    int* cnt = (int*)(F.ws + WS_CTL) + CW_CNT; int* list = (int*)(F.ws + WS_LIST); float* listw = (float*)(F.ws + WS_LISTW);
    LAS int* lcnt = (LAS int*)(F.lds + TAB_OFF + T_LCNT); LAS int* gbase = (LAS int*)(F.lds + TAB_OFF + T_GBASE); LAS int* rec = (LAS int*)(F.lds + TAB_OFF + T_REC);
    LAS float* wscr = (LAS float*)(F.lds + TAB_OFF + T_WSCR + F.wave * 256);
    for (int i = F.tid; i < D * 8; i += 512) { const int c = i >> 3, s = i & 7; const f32x4 w = *(const f32x4*)(F.w_router + (size_t)c * NE + s * 4);
        *(LAS f32x4*)(F.lds + ((c & 3) * 256 + (c >> 2)) * 144 + s * 16) = w; }
    for (int tile = blockIdx.x; tile < NTOK / 64; tile += F.G) {
        if (F.tid < 32) lcnt[F.tid] = 0;
        __syncthreads();
        for (int rr = 0; rr < 8; ++rr) {
            const int rl = F.wave * 8 + rr, row = tile * 64 + rl, b = row / S;
            GAS f32x4* yr = (GAS f32x4*)(F.out + (size_t)row * D) + F.lane;
            f32x4 v[4]; float s = 0.f;
#pragma unroll
            for (int j = 0; j < 4; ++j) { v[j] = yr[64 * j]; s += (v[j].x + v[j].y) + (v[j].z + v[j].w); }
            float mean = wsum(s) * (1.f / D), s2 = 0.f;
#pragma unroll
            for (int j = 0; j < 4; ++j) { v[j] = v[j] - mean; s2 += (v[j].x * v[j].x + v[j].y * v[j].y) + (v[j].z * v[j].z + v[j].w * v[j].w); }
            float rstd = rsqrtf(wsum(s2) * (1.f / D) + LN_EPS);
            s = 0.f;
#pragma unroll
            for (int j = 0; j < 4; ++j) { const f32x4 g = ((const f32x4*)F.ln1_g)[F.lane + 64 * j], bb = ((const f32x4*)F.ln1_b)[F.lane + 64 * j];
                v[j] = v[j] * rstd * g + bb; yr[64 * j] = v[j]; s += (v[j].x + v[j].y) + (v[j].z + v[j].w); }
            mean = wsum(s) * (1.f / D); s2 = 0.f;
#pragma unroll
            for (int j = 0; j < 4; ++j) { v[j] = v[j] - mean; s2 += (v[j].x * v[j].x + v[j].y * v[j].y) + (v[j].z * v[j].z + v[j].w * v[j].w); }
            rstd = rsqrtf(wsum(s2) * (1.f / D) + LN_EPS);
            const f32x4* sh = (const f32x4*)(ada + b * 6 * D + 3 * D) + F.lane; const f32x4* sc = (const f32x4*)(ada + b * 6 * D + 4 * D) + F.lane;
            GAS unsigned* o4 = (GAS unsigned*)(U8 + (size_t)row * D) + F.lane;
#pragma unroll
            for (int j = 0; j < 4; ++j) { v[j] = v[j] * rstd * (sc[64 * j] + 1.0f) + sh[64 * j];
                o4[64 * j] = (unsigned)cvt4_fp8(v[j].x * SC_U, v[j].y * SC_U, v[j].z * SC_U, v[j].w * SC_U); }
            float lg[NE];
#pragma unroll
            for (int e = 0; e < NE; ++e) lg[e] = 0.f;
#pragma unroll
            for (int j = 0; j < 4; ++j)
#pragma unroll
                for (int q = 0; q < 4; ++q) {
                    const LAS f32x4* wp = (const LAS f32x4*)(F.lds + (q * 256 + F.lane + 64 * j) * 144);
                    const float uv = v[j][q];
#pragma unroll
                    for (int s8 = 0; s8 < 8; ++s8) { const f32x4 w = wp[s8]; lg[4 * s8] += uv * w.x; lg[4 * s8 + 1] += uv * w.y; lg[4 * s8 + 2] += uv * w.z; lg[4 * s8 + 3] += uv * w.w; }
                }
            {
                float t16[16], t8[8], t4[4], t2[2], t1;
                const bool b5 = F.lane & 32, b4 = F.lane & 16, b3 = F.lane & 8, b2 = F.lane & 4, b1 = F.lane & 2;
#pragma unroll
                for (int k = 0; k < 16; ++k) { const float keep = b5 ? lg[k + 16] : lg[k], send = b5 ? lg[k] : lg[k + 16]; t16[k] = keep + __shfl_xor(send, 32); }
#pragma unroll
                for (int k = 0; k < 8; ++k) { const float keep = b4 ? t16[k + 8] : t16[k], send = b4 ? t16[k] : t16[k + 8]; t8[k] = keep + __shfl_xor(send, 16); }
#pragma unroll
                for (int k = 0; k < 4; ++k) { const float keep = b3 ? t8[k + 4] : t8[k], send = b3 ? t8[k] : t8[k + 4]; t4[k] = keep + __shfl_xor(send, 8); }
#pragma unroll
                for (int k = 0; k < 2; ++k) { const float keep = b2 ? t4[k + 2] : t4[k], send = b2 ? t4[k] : t4[k + 2]; t2[k] = keep + __shfl_xor(send, 4); }
                { const float keep = b1 ? t2[1] : t2[0], send = b1 ? t2[0] : t2[1]; t1 = keep + __shfl_xor(send, 2); }
                t1 += __shfl_xor(t1, 1);
                const int eidx = (b5 ? 16 : 0) + (b4 ? 8 : 0) + (b3 ? 4 : 0) + (b2 ? 2 : 0) + (b1 ? 1 : 0);
                if ((F.lane & 1) == 0) wscr[eidx] = t1 + F.b_router[eidx];
            }
            LDS_WAIT(); asm volatile("" ::: "memory");
            float lv[NE];
#pragma unroll
            for (int s8 = 0; s8 < 8; ++s8) { const f32x4 w = ((const LAS f32x4*)wscr)[s8]; lv[4 * s8] = w.x; lv[4 * s8 + 1] = w.y; lv[4 * s8 + 2] = w.z; lv[4 * s8 + 3] = w.w; }
            LDS_WAIT(); asm volatile("" ::: "memory");
            int idx[4]; float val[4]; unsigned used = 0u;
#pragma unroll
            for (int k = 0; k < 4; ++k) { int bi = 0; float bv = -3.4e38f;
#pragma unroll
                for (int e = 0; e < NE; ++e) { const bool take = !((used >> e) & 1u) && lv[e] > bv; bv = take ? lv[e] : bv; bi = take ? e : bi; }
                used |= 1u << bi; idx[k] = bi; val[k] = bv; }
            float pr[4], dsum = 0.f;
#pragma unroll
            for (int k = 0; k < 4; ++k) { pr[k] = __expf(val[k] - val[0]); dsum += pr[k]; }
            const float dinv = 1.f / dsum;
            if (F.lane < 4) {
                const int k = F.lane; const int e = k == 0 ? idx[0] : (k == 1 ? idx[1] : (k == 2 ? idx[2] : idx[3])); const float p = (k == 0 ? pr[0] : (k == 1 ? pr[1] : (k == 2 ? pr[2] : pr[3]))) * dinv;
                const int lp = __hip_atomic_fetch_add(lcnt + e, 1, __ATOMIC_RELAXED, __HIP_MEMORY_SCOPE_WORKGROUP);
                rec[(rl * 4 + k) * 3 + 0] = e; rec[(rl * 4 + k) * 3 + 1] = lp; rec[(rl * 4 + k) * 3 + 2] = (int)__float_as_uint(p);
            }
        }
        __syncthreads();
        if (F.tid < 32) gbase[F.tid] = (int)__hip_atomic_fetch_add((unsigned*)cnt + F.tid, (unsigned)lcnt[F.tid], __ATOMIC_RELAXED, __HIP_MEMORY_SCOPE_AGENT);
        __syncthreads();
        if (F.tid < 256) { const int e = rec[F.tid * 3], lp = rec[F.tid * 3 + 1]; const int pos = gbase[e] + lp;
            list[(size_t)e * NTOK + pos] = (tile * 64 + (F.tid >> 2)) * 4 + (F.tid & 3); listw[(size_t)e * NTOK + pos] = __uint_as_float((unsigned)rec[F.tid * 3 + 2]); }
        __syncthreads();
    }
}
__device__ __forceinline__ pg8::MoeTabs moe_tabs(Frame& F, int& ntiles) {
    const int* cnt = (const int*)(F.ws + WS_CTL) + CW_CNT;
    LAS int* tile_e = (LAS int*)(F.lds + TAB_OFF + T_TILE_E); LAS int* tile0 = (LAS int*)(F.lds + TAB_OFF + T_TILE0); LAS int* lc = (LAS int*)(F.lds + TAB_OFF + T_CNT); LAS int* lnt = (LAS int*)(F.lds + TAB_OFF + T_NT);
    __syncthreads();
    if (F.tid == 0) { int nt = 0;
        for (int e = 0; e < NE; ++e) { const int c = cnt[e]; lc[e] = c; tile0[e] = nt; const int t = (c + 255) >> 8; for (int i = 0; i < t; ++i) tile_e[nt + i] = e; nt += t; }
        tile0[NE] = nt; lnt[0] = nt; }
    __syncthreads();
    ntiles = lnt[0];
    pg8::MoeTabs T; T.tile_e = tile_e; T.tile0 = tile0; T.cnt = lc; return T;
}
__device__ __forceinline__ void p10_final(Frame& F) {
    const float* ada = (const float*)(F.ws + WS_ADA); const bf16_t* YB = (const bf16_t*)(F.ws + WS_YB);
    const int gw = F.vcu * NWAVES + F.wave, NGW = F.G * NWAVES;
    for (int row = gw; row < NTOK; row += NGW) {
        GAS f32x4* xr = (GAS f32x4*)(F.out + (size_t)row * D) + F.lane;
        const f32x4* gate = (const f32x4*)(ada + (row / S) * 6 * D + 5 * D) + F.lane;
        f32x4 v[4]; float s = 0.f;
#pragma unroll
        for (int j = 0; j < 4; ++j) {
            f32x4 f = {0.f, 0.f, 0.f, 0.f};
#pragma unroll
            for (int k = 0; k < 4; ++k) { const u32x2 y = *((const u32x2*)(YB + ((size_t)row * 4 + k) * D) + F.lane + 64 * j); f.x += bflo(y.x); f.y += bfhi(y.x); f.z += bflo(y.y); f.w += bfhi(y.y); }
            v[j] = xr[64 * j] * DN_ALPHA + (gate[64 * j] + 1.0f) * f; s += (v[j].x + v[j].y) + (v[j].z + v[j].w);
        }
        const float mean = wsum(s) * (1.f / D); float s2 = 0.f;
#pragma unroll
        for (int j = 0; j < 4; ++j) { v[j] = v[j] - mean; s2 += (v[j].x * v[j].x + v[j].y * v[j].y) + (v[j].z * v[j].z + v[j].w * v[j].w); }
        const float rstd = rsqrtf(wsum(s2) * (1.f / D) + LN_EPS);
#pragma unroll
        for (int j = 0; j < 4; ++j) xr[64 * j] = v[j] * rstd * ((const f32x4*)F.ln2_g)[F.lane + 64 * j] + ((const f32x4*)F.ln2_b)[F.lane + 64 * j];
    }
}

constexpr int NPHASES = 11;
constexpr int CW_BAR = 4096;
__global__ void __launch_bounds__(NWAVES * 64, 2) mk_fwd(Args args) {
    extern __shared__ __attribute__((aligned(16))) unsigned char lds_raw[];
    Frame F;
    F.lds = (LAS unsigned char*)lds_raw;
    F.tid = threadIdx.x; F.lane = F.tid & 63; F.wave = __builtin_amdgcn_readfirstlane(F.tid >> 6);
    F.G = gridDim.x; { const int bx = blockIdx.x; F.vcu = (F.G % 8 == 0) ? (bx % 8) * (F.G / 8) + bx / 8 : bx; }
    F.x = (const float*)args.in[0]; F.c = (const float*)args.in[1]; F.positions = (const int*)args.in[2]; F.w_ada = (const float*)args.in[3]; F.b_ada = (const float*)args.in[4];
    F.w_in = (const float*)args.in[5]; F.pool_w = (const float*)args.in[6]; F.pool_scale = (const float*)args.in[7]; F.w_pool_out = (const float*)args.in[8]; F.w_attn_out = (const float*)args.in[9];
    F.w_o = (const float*)args.in[10]; F.ln1_g = (const float*)args.in[11]; F.ln1_b = (const float*)args.in[12]; F.w_router = (const float*)args.in[13]; F.b_router = (const float*)args.in[14];
    F.w_gate = (const float*)args.in[15]; F.b_gate = (const float*)args.in[16]; F.w_up = (const float*)args.in[17]; F.b_up = (const float*)args.in[18]; F.w_down = (const float*)args.in[19];
    F.b_down = (const float*)args.in[20]; F.ln2_g = (const float*)args.in[21]; F.ln2_b = (const float*)args.in[22];
    F.out = args.out; F.ws = args.ws;
    unsigned char* ws = args.ws;
    volatile LAS unsigned* MISC = (volatile LAS unsigned*)(F.lds + TAB_OFF + T_MISC);
    if (F.tid < 32) MISC[F.tid] = 0u;
    __syncthreads();
    const int lo = args.ph_lo, hi = args.ph_hi;
    XcdBarrier bar; bar.bar = (unsigned*)(ws + WS_CTL) + CW_BAR; bar.x = 0; bar.st = nullptr;
    if (hi - lo > 1) bar = xcd_barrier_post((unsigned*)(ws + WS_CTL) + CW_BAR, MISC + 8);
#ifndef PH_EN
#define PH_EN 0x7ff
#endif
#define IN(k) (((PH_EN >> (k)) & 1) && lo <= (k) && (k) < hi)
#define BOTH(k) (IN(k) && IN((k) + 1))
#define GRID_BAR(k) do { if (BOTH(k)) xcd_barrier(bar); } while (0)
    bf16_t *U = (bf16_t*)(ws + WS_U), *ACAT = (bf16_t*)(ws + WS_ACAT), *H = (bf16_t*)(ws + WS_H), *YB = (bf16_t*)(ws + WS_YB); const bf16_t* U8 = (const bf16_t*)(ws + WS_U8);

    if (IN(0)) { p0_prologue(F); GRID_BAR(0); }
    if (IN(1)) { p1_lnmod(F); GRID_BAR(1); }
    if (IN(2)) {
        pg8::ProbDense<1024> P{U, (const bf16_t*)(ws + WS_WIN)}; pg8::StaticOrder S_; S_.init(NTOK, INW, F.G, (int)blockIdx.x);
        pg8::EpiProj E{(bf16_t*)(ws + WS_XP), (bf16_t*)(ws + WS_Q), (bf16_t*)(ws + WS_K), (bf16_t*)(ws + WS_V), (bf16_t*)(ws + WS_GP), (bf16_t*)(ws + WS_GA), (const float*)(ws + WS_ROPE)};
        pg8::gemm_phase<pg8::ProbDense<1024>, pg8::EpiProj, pg8::StaticOrder, true>(F.lds, P, S_, E);
        GRID_BAR(2);
    }
    if (IN(3)) { p3_attention(F); p3_pool(F); GRID_BAR(3); }
    if (IN(4)) { p4_merge(F); GRID_BAR(4); }
    if (IN(5)) {
        pg8::ProbDense<768> P{ACAT, (const bf16_t*)(ws + WS_WCAT)}; pg8::StaticOrder S_; S_.init(NTOK, D, F.G, (int)blockIdx.x);
        pg8::EpiMerged E{(const bf16_t*)(ws + WS_GP), (const bf16_t*)(ws + WS_GA), U};
        pg8::gemm_phase<pg8::ProbDense<768>, pg8::EpiMerged, pg8::StaticOrder, false>(F.lds, P, S_, E);
        GRID_BAR(5);
    }
    if (IN(6)) {
        pg8::ProbDense<1024> P{U, (const bf16_t*)(ws + WS_WO)}; pg8::StaticOrder S_; S_.init(NTOK, D, F.G, (int)blockIdx.x);
        pg8::EpiWo E{F.x, (const float*)(ws + WS_ADA), F.out};
        pg8::gemm_phase<pg8::ProbDense<1024>, pg8::EpiWo, pg8::StaticOrder, false>(F.lds, P, S_, E);
        GRID_BAR(6);
    }
    if (IN(7)) { p7_router(F); GRID_BAR(7); }
    if (IN(8)) {
        int ntiles; const pg8::MoeTabs T = moe_tabs(F, ntiles);
        pg8::ProbGU P{U8, (const bf16_t*)(ws + WS_WGU), (const int*)(ws + WS_LIST), T}; pg8::MoeOrder S_; S_.init(ntiles, 8, F.G, (int)blockIdx.x);
        pg8::EpiGU E{F.b_gate, F.b_up, H, T};
        pg8::gemm_phase<pg8::ProbGU, pg8::EpiGU, pg8::MoeOrder, true, true>(F.lds, P, S_, E);
        GRID_BAR(8);
    }
    if (IN(9)) {
        int ntiles; const pg8::MoeTabs T = moe_tabs(F, ntiles);
        pg8::ProbDown P{H, (const bf16_t*)(ws + WS_WDN), T}; pg8::MoeOrder S_; S_.init(ntiles, 4, F.G, (int)blockIdx.x);
        pg8::EpiDown E{F.b_down, (const float*)(ws + WS_LISTW), (const int*)(ws + WS_LIST), YB, T};
        pg8::gemm_phase<pg8::ProbDown, pg8::EpiDown, pg8::MoeOrder, true, true>(F.lds, P, S_, E);
        GRID_BAR(9);
    }
    if (IN(10)) { p10_final(F); }
#undef IN
#undef BOTH
#undef GRID_BAR
}


#ifndef MK_SPLIT
#define MK_SPLIT 0
#endif
extern "C" void kernel_launch(void* const* d_in, const int* in_sizes, int n_in, void* d_out, int out_size, void* d_ws, size_t ws_size, hipStream_t stream) {
    if (ws_size < WS_END || n_in < 23) { fprintf(stderr, "kernel_launch: workspace too small or wrong input count\n"); return; }
    static int grid = 0;
    if (grid == 0) {
        int dev = 0, cus = 0;
        if (hipGetDevice(&dev) != hipSuccess || hipDeviceGetAttribute(&cus, hipDeviceAttributeMultiprocessorCount, dev) != hipSuccess) { grid = -1; return; }
        if (hipFuncSetAttribute((const void*)mk_fwd, hipFuncAttributeMaxDynamicSharedMemorySize, LDS_BYTES) != hipSuccess) { fprintf(stderr, "kernel_launch: hipFuncSetAttribute failed\n"); grid = -1; return; }
        int per_cu = 0;
        if (hipOccupancyMaxActiveBlocksPerMultiprocessor(&per_cu, (const void*)mk_fwd, NWAVES * 64, LDS_BYTES) != hipSuccess || per_cu < 1) fprintf(stderr, "kernel_launch: occupancy query says %d\n", per_cu);
        (void)hipGetLastError();
        grid = cus;
    }
    if (grid < 0) return;
    unsigned char* ws = (unsigned char*)d_ws;
    (void)hipMemsetAsync(ws + WS_CTL, 0, CTL_BYTES, stream);
    Args a{};
    for (int i = 0; i < 23; ++i) a.in[i] = d_in[i];
    a.out = (float*)d_out; a.ws = ws;
    if (!MK_SPLIT) { a.ph_lo = 0; a.ph_hi = NPHASES; hipLaunchKernelGGL(mk_fwd, dim3(grid), dim3(NWAVES * 64), LDS_BYTES, stream, a); return; }
    for (int ph = 0; ph < NPHASES; ++ph) { a.ph_lo = ph; a.ph_hi = ph + 1; hipLaunchKernelGGL(mk_fwd, dim3(grid), dim3(NWAVES * 64), LDS_BYTES, stream, a); }
}
```

```cpp
#include <hip/hip_runtime.h>
#include <stdint.h>
#include <stdio.h>
#include <string.h>

typedef unsigned short bf16_t;
typedef unsigned u32x4 __attribute__((ext_vector_type(4)));

constexpr int NB = 2, S = 8192, D = 1024, NTOK = NB * S;
constexpr int POOLW = 512, PGRP = 128;
constexpr int HD = 64, NH = 12, AW = 768, AOW = 256;
constexpr int INW = POOLW + 3 * AW + 2 * D;
constexpr int NE = 32, TOPK = 4, NASSIGN = NTOK * TOPK;
constexpr int MAXTILES = 288, PMAX = MAXTILES * 256;
constexpr float LN_EPS = 1e-5f;
constexpr float DN_ALPHA = 1.189207115002721f;
constexpr float SW_ALPHA = 1.702f, SW_LIMIT = 7.0f;

constexpr size_t MiB = 1u << 20;
constexpr size_t WS_CTL = 0, CTL_BYTES = 1 * MiB;
constexpr size_t WS_ADA = 1 * MiB;
constexpr size_t WS_ROPE = 2 * MiB;
constexpr size_t WS_LIST = 4 * MiB;
constexpr size_t WS_LISTW = 6 * MiB;
constexpr size_t WS_WIN = 8 * MiB;
constexpr size_t WS_WPOOL = 18 * MiB;
constexpr size_t WS_WCAT = 19 * MiB;
constexpr size_t WS_WO = 21 * MiB;
constexpr size_t WS_WDN = 24 * MiB;
constexpr size_t WS_WGU = 56 * MiB;
constexpr size_t WS_U = 120 * MiB;
constexpr size_t WS_U8 = 152 * MiB;
constexpr size_t WS_XP = 168 * MiB;
constexpr size_t WS_Q = 184 * MiB, WS_K = 208 * MiB, WS_V = 232 * MiB;
constexpr size_t WS_GP = 256 * MiB, WS_GA = 288 * MiB;
constexpr size_t WS_ACAT = 320 * MiB;
constexpr size_t WS_LSE = 344 * MiB;
constexpr size_t WS_OG = 346 * MiB;
constexpr size_t WS_H = 168 * MiB;
constexpr size_t WS_YB = 256 * MiB;
constexpr size_t WS_END = 384 * MiB;
constexpr int CW_CNT = 1024;
constexpr float SC_W = 256.f, SC_U = 8.f, SC_H = 8.f;

__device__ __forceinline__ float bf2f(bf16_t v) { return __uint_as_float((unsigned)v << 16); }
__device__ __forceinline__ bf16_t f2bf(float f) { unsigned u = __float_as_uint(f); return (bf16_t)((u + 0x7fffu + ((u >> 16) & 1u)) >> 16); }
__device__ __forceinline__ float sigmoidf_(float x) { return 1.0f / (1.0f + __expf(-x)); }
__device__ __forceinline__ float wave_sum(float v) {
#pragma unroll
    for (int o = 1; o < 64; o <<= 1) v += __shfl_xor(v, o);
    return v;
}

__device__ __forceinline__ int rowmap(int n, int mode) { return mode == 0 ? n : (256 * (n >> 7) + (n & 127) + (mode == 2 ? 128 : 0)); }
__constant__ float c_invfreq[8] = {1.0f, 0.1939227432012558f, 0.03760603070259094f, 0.007292664609849453f, 0.0014142135623842478f, 0.00027424818836152554f, 5.318296098266728e-05f, 1.0313386155758053e-05f};
#define LAS __attribute__((address_space(3)))
#define GAS __attribute__((address_space(1)))
typedef short bf16x8 __attribute__((ext_vector_type(8)));
typedef short s16x4 __attribute__((ext_vector_type(4)));
typedef float f32x4 __attribute__((ext_vector_type(4)));
typedef float f32x2 __attribute__((ext_vector_type(2)));
typedef unsigned u32x2 __attribute__((ext_vector_type(2)));
typedef GAS unsigned gu32;
#define RLX_AGENT __ATOMIC_RELAXED, __HIP_MEMORY_SCOPE_AGENT
#define LDS_WAIT() asm volatile("s_waitcnt lgkmcnt(0)" ::: "memory")
#define VM_WAIT() asm volatile("s_waitcnt vmcnt(0)" ::: "memory")

constexpr int NWAVES = 8;
constexpr int RING_BYTES = 131072;
constexpr int QREG_OFF = RING_BYTES;
constexpr int TAB_OFF = 147456;
constexpr int LDS_BYTES = 163840;
constexpr int T_MISC = 0;
constexpr int T_TILE_E = 256;
constexpr int T_TILE0 = 256 + 1280;
constexpr int T_CNT = T_TILE0 + 160;
constexpr int T_NT = T_CNT + 128;
constexpr int T_LCNT = T_NT + 16;
constexpr int T_GBASE = T_LCNT + 128;
constexpr int T_REC = T_GBASE + 128;
constexpr int T_WSCR = T_REC + 3072;
constexpr int T_END = T_WSCR + 2048;
static_assert(TAB_OFF + T_END <= LDS_BYTES, "LDS map");

__device__ __forceinline__ unsigned cvt_pk_bf16(float lo, float hi) { unsigned r; asm volatile("v_cvt_pk_bf16_f32 %0, %1, %2" : "=v"(r) : "v"(lo), "v"(hi)); return r; }
__device__ __forceinline__ float bflo(unsigned w) { return __uint_as_float(w << 16); }
__device__ __forceinline__ float bfhi(unsigned w) { return __uint_as_float(w & 0xffff0000u); }
__device__ __forceinline__ float fast_sigmoid(float x) { return __builtin_amdgcn_rcpf(1.0f + __expf(-x)); }

#ifndef SW_FP8
#define SW_FP8 0
#endif
__device__ __forceinline__ unsigned sw_e4m3(float x) {
    const unsigned u = __float_as_uint(x), s = (u >> 24) & 0x80u, ua = u & 0x7fffffffu; const float a = __uint_as_float(ua);
    unsigned m;
    if (a < 0.015625f) m = (unsigned)__float2int_rn(a * 512.0f);
    else { const unsigned r = ua + 0x7ffffu + ((ua >> 20) & 1u); m = (r >> 20) - (120u << 3); m = m > 0x7eu ? 0x7eu : m; }
    return s | m;
}
__device__ __forceinline__ int cvt4_fp8(float a, float b, float c, float d) {
    if (SW_FP8) return (int)(sw_e4m3(a) | (sw_e4m3(b) << 8) | (sw_e4m3(c) << 16) | (sw_e4m3(d) << 24));
    int w = __builtin_amdgcn_cvt_pk_fp8_f32(a, b, 0, false); return __builtin_amdgcn_cvt_pk_fp8_f32(c, d, w, true);
}
#define XB_TMO      128
#define XB_XCNT(j)  (256  + 64 * (j))
#define XB_XSUB(j)  (1280 + 64 * (j))
#define XB_XGEN(j)  (2304 + 64 * (j))
#define XB_TOP      3328
#define XB_TOPGEN   3392
#define XCD_BAR_WORDS 3456
#define XB_SPIN_CAP (1u << 18)
__device__ __forceinline__ unsigned xb_ld(unsigned* p)              { return __hip_atomic_load(p, __ATOMIC_RELAXED, __HIP_MEMORY_SCOPE_AGENT); }
__device__ __forceinline__ unsigned xb_add(unsigned* p, unsigned v) { return __hip_atomic_fetch_add(p, v, __ATOMIC_RELAXED, __HIP_MEMORY_SCOPE_AGENT); }
__device__ __forceinline__ unsigned xb_xcc_id() { return (unsigned)__builtin_amdgcn_s_getreg((3 << 11) | 20) & 0xFu; }
#define XB_SPIN(cond, bar) do { unsigned _sp = 0; while (cond) { __builtin_amdgcn_s_sleep(1); \
    if ((++_sp & 255u) == 0u) { if (xb_ld(&(bar)[XB_TMO])) break; if (_sp > XB_SPIN_CAP) { atomicAdd(&(bar)[XB_TMO], 1u); break; } } } } while (0)
struct XcdBarrier { unsigned* bar; unsigned x; volatile LAS unsigned* st; };
__device__ __forceinline__ XcdBarrier xcd_barrier_post(unsigned* bar, volatile LAS unsigned* st) {
    XcdBarrier b; b.bar = bar; b.x = xb_xcc_id(); b.st = st;
    if (threadIdx.x == 0) (void)xb_add(&bar[XB_XCNT(b.x)], 1u);
    return b;
}
__device__ __forceinline__ void xcd_barrier_complete(unsigned* bar, unsigned x, unsigned& nloc, unsigned& nx) {
    const unsigned G = gridDim.x * gridDim.y * gridDim.z;
    unsigned sum, cnt, mine, sp = 0u;
    for (;;) {
        sum = 0u; cnt = 0u; mine = 0u;
#pragma unroll
        for (unsigned j = 0; j < 16; ++j) { const unsigned c = xb_ld(&bar[XB_XCNT(j)]); sum += c; cnt += (c > 0u) ? 1u : 0u; mine = (j == x) ? c : mine; }
        if (sum == G) break;
        __builtin_amdgcn_s_sleep(1);
        if ((++sp & 255u) == 0u) { if (xb_ld(&bar[XB_TMO])) break; if (sp > XB_SPIN_CAP) { atomicAdd(&bar[XB_TMO], 1u); break; } }
    }
    nloc = mine > 0u ? mine : 1u; nx = cnt > 0u ? cnt : 1u;
}
__device__ __forceinline__ void xcd_barrier(const XcdBarrier& b) {
    asm volatile("s_waitcnt vmcnt(0)" ::: "memory");
    __syncthreads();
    if (threadIdx.x == 0) {
        unsigned* bar = b.bar;
        __builtin_amdgcn_s_waitcnt(0);
        unsigned nloc = b.st[0], nx = b.st[1];
        if (nloc == 0u) { xcd_barrier_complete(bar, b.x, nloc, nx); b.st[0] = nloc; b.st[1] = nx; }
        const unsigned old = xb_add(&bar[XB_XSUB(b.x)], 1u);
        const unsigned gen = old / nloc;
        if (old + 1u == (gen + 1u) * nloc) {
            __builtin_amdgcn_fence(__ATOMIC_RELEASE, "agent");
            asm volatile("s_waitcnt vmcnt(0)" ::: "memory");
            const unsigned og = xb_add(&bar[XB_TOP], 1u);
            const unsigned tg = og / nx;
            if (og + 1u == (tg + 1u) * nx) xb_add(&bar[XB_TOPGEN], 1u);
            else XB_SPIN(xb_ld(&bar[XB_TOPGEN]) == tg, bar);
            __builtin_amdgcn_fence(__ATOMIC_ACQUIRE, "agent");
            xb_add(&bar[XB_XGEN(b.x)], 1u);
            asm volatile("s_waitcnt vmcnt(0)" ::: "memory");
        } else {
            XB_SPIN(xb_ld(&bar[XB_XGEN(b.x)]) == gen, bar);
            __builtin_amdgcn_fence(__ATOMIC_ACQUIRE, "agent");
            asm volatile("s_waitcnt vmcnt(0)" ::: "memory");
        }
    }
    __syncthreads();
}

#ifndef FP8_PLAIN
#define FP8_PLAIN 0
#endif
namespace pg8 {
constexpr int BM = 256, BK = 64, HALF = 128, HTB = HALF * BK * 2, STAGE_BYTES = 8 * HTB, NXCD = 8, WGM = 8;
__host__ __device__ __forceinline__ int lds_byte(int r, int c) { const int st = (r >> 4) * 2 + (c >> 5), rr = r & 15, cc = c & 31, ob = rr * 64 + cc * 2; return st * 1024 + (ob ^ (((ob >> 9) & 1) << 5)); }
__host__ __device__ __forceinline__ void stage_rc(int b, int& R, int& C) { const int st = b / 1024, sb = b % 1024, swz = sb ^ (((sb >> 9) & 1) << 5); R = (st >> 1) * 16 + swz / 64; C = (st & 1) * 32 + (swz % 64) / 2; }
__host__ __device__ __forceinline__ int perm32(int rho) { const int n = rho >> 4, i = rho & 15; return 8 * (i >> 2) + 4 * n + (i & 3); }
struct Unit { int pm, pn; };
typedef int v8i32 __attribute__((ext_vector_type(8)));
typedef int v4i32 __attribute__((ext_vector_type(4)));
struct StaticOrder {
    int nM, nN, nwg, G, c;
    __device__ void init(int M, int N, int G_, int c_) { nM = M / BM; nN = N / BM; nwg = nM * nN; G = G_; c = c_; }
    __device__ bool next(int i, Unit& u) const {
        const long L = (long)i * G + c; if (L >= nwg) return false;
        int wgid = (int)L; { const int q = nwg / NXCD, r = nwg % NXCD, xcd = wgid % NXCD, off = wgid / NXCD; wgid = (xcd < r ? xcd * (q + 1) : r * (q + 1) + (xcd - r) * q) + off; }
        const int nig = WGM * nN, gid = wgid / nig, fm = gid * WGM, gsz = (nM - fm) < WGM ? (nM - fm) : WGM;
        u.pm = fm + ((wgid % nig) % gsz); u.pn = (wgid % nig) / gsz; return true;
    }
};
struct MoeOrder {
    int nN, nunits, G, c;
    __device__ void init(int ntiles, int nN_, int G_, int c_) { nN = nN_; nunits = ntiles * nN_; G = G_; c = c_; }
    __device__ bool next(int i, Unit& u) const { const int L = i * G + c; if (L >= nunits) return false; u.pm = L / nN; u.pn = L % nN; return true; }
};

template <class Prob, class Epi, class Sched, bool ALIGN_EPI, bool FP8 = false>
__device__ __forceinline__ void gemm_phase(LAS unsigned char* lds, const Prob& P, const Sched& S, const Epi& E) {
    const int tid = threadIdx.x, wid = __builtin_amdgcn_readfirstlane(tid >> 6), lane = tid & 63, wr = wid >> 2, wc = wid & 3, fr = lane & 15, fq = lane >> 4;
    constexpr int K = Prob::K, nt = K / BK;
    static_assert(nt % 2 == 0 && nt >= 4, "K must be a multiple of 128");
    unsigned voffB[2]; int sR[2], sC[2];
#pragma unroll
    for (int i = 0; i < 2; ++i) { int R, C; stage_rc(tid * 16 + i * 8192, R, C); const int Rb = Epi::PERM ? ((R & ~31) + perm32(R & 31)) : R;
        voffB[i] = (unsigned)(Rb * K + C) * 2u; sR[i] = R; sC[i] = C; }
    constexpr size_t kstep = (size_t)(BK * 2);
    constexpr size_t hstepB = (size_t)HALF * K * 2;
    const unsigned ldsw = (unsigned)wid * 1024u;
    const int aoff = lds_byte(wr * 64 + fr, fq * 8), boff = lds_byte(wc * 32 + fr, fq * 8);
#define PG8_SA(b, h) (((b) * 2 + (h)) * HTB)
#define PG8_SB(b, h) ((4 + (b) * 2 + (h)) * HTB)
#define PG8_STAGE(bufoff, gbase, voff) do { _Pragma("unroll") for (int _i = 0; _i < 2; ++_i) \
        __builtin_amdgcn_global_load_lds((const unsigned*)((const char*)(gbase) + (voff)[_i]), (LAS unsigned*)(lds + (bufoff) + ldsw + _i * 8192), 16, 0, 0); } while (0)
#define PG8_LDA(dst, b, h) do { _Pragma("unroll") for (int m = 0; m < 4; ++m) { dst[m].lo = *(const LAS v4i32*)(lds + PG8_SA(b, h) + aoff + m * 2048); dst[m].hi = *(const LAS v4i32*)(lds + PG8_SA(b, h) + aoff + m * 2048 + 1024); } } while (0)
#define PG8_LDB(dst, b, h) do { _Pragma("unroll") for (int n = 0; n < 2; ++n) { dst[n].lo = *(const LAS v4i32*)(lds + PG8_SB(b, h) + boff + n * 2048); dst[n].hi = *(const LAS v4i32*)(lds + PG8_SB(b, h) + boff + n * 2048 + 1024); } } while (0)
#define PG8_MMA(ai, bj, At, Bt) do { __builtin_amdgcn_s_setprio(1); _Pragma("unroll") for (int m = 0; m < 4; ++m) _Pragma("unroll") for (int n = 0; n < 2; ++n) { \
        if constexpr (FP8) { if constexpr (FP8_PLAIN) { _Pragma("unroll") for (int k4 = 0; k4 < 4; ++k4) { \
                const long bb = ((long)(unsigned)Bt[n][2 * k4 + 1] << 32) | (unsigned)Bt[n][2 * k4], aa = ((long)(unsigned)At[m][2 * k4 + 1] << 32) | (unsigned)At[m][2 * k4]; \
                acc[ai][bj][m][n] = __builtin_amdgcn_mfma_f32_16x16x32_fp8_fp8(bb, aa, acc[ai][bj][m][n], 0, 0, 0); } } \
            else acc[ai][bj][m][n] = __builtin_amdgcn_mfma_scale_f32_16x16x128_f8f6f4(Bt[n], At[m], acc[ai][bj][m][n], 0, 0, 0, Prob::SCALE_B, 0, Prob::SCALE_A); } \
        else { const v4i32 bl_ = Bt[n].lo, bh_ = Bt[n].hi, al_ = At[m].lo, ah_ = At[m].hi;     \
               acc[ai][bj][m][n] = __builtin_amdgcn_mfma_f32_16x16x32_bf16(__builtin_bit_cast(bf16x8, bl_), __builtin_bit_cast(bf16x8, al_), acc[ai][bj][m][n], 0, 0, 0); \
               acc[ai][bj][m][n] = __builtin_amdgcn_mfma_f32_16x16x32_bf16(__builtin_bit_cast(bf16x8, bh_), __builtin_bit_cast(bf16x8, ah_), acc[ai][bj][m][n], 0, 0, 0); } } \
        __builtin_amdgcn_s_setprio(0); } while (0)
#define PG8_WAIT_V(n) asm volatile("s_waitcnt vmcnt(" #n ")" ::: "memory")
#define PG8_WAIT_L(n) asm volatile("s_waitcnt lgkmcnt(" #n ")" ::: "memory")
#define PG8_BAR __builtin_amdgcn_s_barrier()
#define PG8_SCHED __builtin_amdgcn_sched_barrier(0)
#define PG8_SCHED8 do { if constexpr (FP8) __builtin_amdgcn_sched_barrier(0); } while (0)
#define PG8_PIN(ai) do { if constexpr (FP8) { _Pragma("unroll") for (int bj_ = 0; bj_ < 2; ++bj_) _Pragma("unroll") for (int m_ = 0; m_ < 4; ++m_) asm volatile("" : "+v"(acc[ai][bj_][m_][0]), "+v"(acc[ai][bj_][m_][1])); } } while (0)
    Unit cur, nxt; int ui = 0;
    if (!S.next(0, cur)) return;
    f32x4 acc[2][2][4][2];
#pragma unroll
    for (int a = 0; a < 2; ++a)
#pragma unroll
        for (int b = 0; b < 2; ++b)
#pragma unroll
            for (int m = 0; m < 4; ++m)
#pragma unroll
                for (int n = 0; n < 2; ++n) acc[a][b][m][n] = (f32x4){0.f, 0.f, 0.f, 0.f};
    v8i32 At[4], B0[2], B1[2];
    unsigned cv0[2], cv1[2], nv0[2], nv1[2];
    const char* cA = P.a_ptr(cur); const char* cB = P.b_ptr(cur);
    P.a_voff(cur, sR, sC, cv0, cv1);
    PG8_STAGE(PG8_SB(0, 0), cB, voffB); PG8_STAGE(PG8_SB(0, 1), cB + hstepB, voffB); PG8_STAGE(PG8_SA(0, 0), cA, cv0); PG8_STAGE(PG8_SA(0, 1), cA, cv1);
    if (wr == 1) PG8_BAR;
    PG8_WAIT_V(2); PG8_BAR;
    PG8_STAGE(PG8_SB(1, 0), cB + kstep, voffB); PG8_STAGE(PG8_SA(1, 0), cA + kstep, cv0); PG8_STAGE(PG8_SB(1, 1), cB + hstepB + kstep, voffB);
    PG8_WAIT_V(6); PG8_BAR;
    for (;;) {
        const bool has_next = S.next(ui + 1, nxt);
        const char* nA = has_next ? P.a_ptr(nxt) : cA; const char* nB = has_next ? P.b_ptr(nxt) : cB;
        if (has_next) P.a_voff(nxt, sR, sC, nv0, nv1); else { nv0[0] = cv0[0]; nv0[1] = cv0[1]; nv1[0] = cv1[0]; nv1[1] = cv1[1]; }
        for (int t = 0; t < nt; t += 2) {
            if constexpr (Epi::HAS_MID) { if (t == Epi::MID_T) E.mid(acc, cur, wr, wc, fr, fq); }
            const bool last = (t == nt - 2);
            const char* a1 = cA + (size_t)(t + 1) * kstep;
            const char* a2 = last ? nA : cA + (size_t)(t + 2) * kstep; const char* b2 = last ? nB : cB + (size_t)(t + 2) * kstep;
            const char* a3 = a2 + kstep; const char* b3 = b2 + kstep;
            unsigned v20[2], v21[2];
            v20[0] = last ? nv0[0] : cv0[0]; v20[1] = last ? nv0[1] : cv0[1]; v21[0] = last ? nv1[0] : cv1[0]; v21[1] = last ? nv1[1] : cv1[1];
            PG8_LDB(B0, 0, 0); PG8_LDB(B1, 0, 1); PG8_SCHED; PG8_LDA(At, 0, 0); PG8_STAGE(PG8_SA(1, 1), a1, cv1);
            PG8_WAIT_V(8); PG8_WAIT_L(0); PG8_BAR; PG8_SCHED8; PG8_MMA(0, 0, At, B0); PG8_MMA(0, 1, At, B1); PG8_PIN(0); PG8_SCHED8; PG8_BAR; PG8_SCHED;
            PG8_LDA(At, 0, 1); PG8_STAGE(PG8_SB(0, 0), b2, voffB); PG8_STAGE(PG8_SB(0, 1), b2 + hstepB, voffB); PG8_STAGE(PG8_SA(0, 0), a2, v20);
            PG8_WAIT_V(8); PG8_WAIT_L(0); PG8_BAR; PG8_SCHED8; PG8_MMA(1, 0, At, B0); PG8_MMA(1, 1, At, B1); PG8_PIN(1); PG8_SCHED8; PG8_BAR; PG8_SCHED;
            PG8_LDB(B0, 1, 0); PG8_LDB(B1, 1, 1); PG8_SCHED; PG8_LDA(At, 1, 0); PG8_STAGE(PG8_SA(0, 1), a2, v21);
            PG8_WAIT_V(8); PG8_WAIT_L(0); PG8_BAR; PG8_SCHED8; PG8_MMA(0, 0, At, B0); PG8_MMA(0, 1, At, B1); PG8_PIN(0); PG8_SCHED8; PG8_BAR; PG8_SCHED;
            PG8_LDA(At, 1, 1); PG8_STAGE(PG8_SB(1, 0), b3, voffB); PG8_STAGE(PG8_SB(1, 1), b3 + hstepB, voffB); PG8_STAGE(PG8_SA(1, 0), a3, v20);
            PG8_WAIT_V(8); PG8_WAIT_L(0); PG8_BAR; PG8_SCHED8; PG8_MMA(1, 0, At, B0); PG8_MMA(1, 1, At, B1); PG8_PIN(1); PG8_SCHED8; PG8_BAR; PG8_SCHED;
        }
        if constexpr (ALIGN_EPI) { if (wr == 0) PG8_BAR; }
        E(acc, cur, wr, wc, fr, fq);
        if (!has_next) break;
#pragma unroll
        for (int a = 0; a < 2; ++a)
#pragma unroll
            for (int b = 0; b < 2; ++b)
#pragma unroll
                for (int m = 0; m < 4; ++m)
#pragma unroll
                    for (int n = 0; n < 2; ++n) acc[a][b][m][n] = (f32x4){0.f, 0.f, 0.f, 0.f};
        cur = nxt; cA = nA; cB = nB; ++ui;
        cv0[0] = nv0[0]; cv0[1] = nv0[1]; cv1[0] = nv1[0]; cv1[1] = nv1[1];
        if constexpr (ALIGN_EPI) { if (wr == 1) PG8_BAR; }
    }
    PG8_WAIT_V(0);
    if constexpr (!ALIGN_EPI) { if (wr == 0) PG8_BAR; }
    PG8_BAR;
#undef PG8_SA
#undef PG8_SB
#undef PG8_STAGE
#undef PG8_LDA
#undef PG8_LDB
#undef PG8_MMA
#undef PG8_WAIT_V
#undef PG8_WAIT_L
#undef PG8_BAR
#undef PG8_SCHED
#undef PG8_SCHED8
#undef PG8_PIN
}

template <int K_> struct ProbDense {
    static constexpr int K = K_, SCALE_A = 0x7f7f7f7f, SCALE_B = 0x7f7f7f7f;
    const bf16_t* A; const bf16_t* Bt;
    __device__ __forceinline__ const char* a_ptr(const Unit& u) const { return (const char*)A + (size_t)u.pm * BM * K * 2; }
    __device__ __forceinline__ const char* b_ptr(const Unit& u) const { return (const char*)Bt + (size_t)u.pn * BM * K * 2; }
    __device__ __forceinline__ void a_voff(const Unit&, const int (&R)[2], const int (&C)[2], unsigned (&v0)[2], unsigned (&v1)[2]) const {
#pragma unroll
        for (int i = 0; i < 2; ++i) { v0[i] = (unsigned)(R[i] * K + C[i]) * 2u; v1[i] = (unsigned)((R[i] + HALF) * K + C[i]) * 2u; }
    }
};
struct MoeTabs { const LAS int* tile_e; const LAS int* tile0; const LAS int* cnt; };
struct ProbGU {
    static constexpr int K = 512, SCALE_A = 0x7c7c7c7c  , SCALE_B = 0x77777777  ;
    const bf16_t* U2; const bf16_t* W; const int* list; MoeTabs T;
    __device__ __forceinline__ const char* a_ptr(const Unit&) const { return (const char*)U2; }
    __device__ __forceinline__ const char* b_ptr(const Unit& u) const { const int e = T.tile_e[u.pm]; return (const char*)W + ((size_t)e * 2048 + (size_t)u.pn * BM) * K * 2; }
    __device__ __forceinline__ void a_voff(const Unit& u, const int (&R)[2], const int (&C)[2], unsigned (&v0)[2], unsigned (&v1)[2]) const {
        const int e = T.tile_e[u.pm], p0 = (u.pm - T.tile0[e]) * BM, n = T.cnt[e]; const int* L = list + (size_t)e * NTOK;
#pragma unroll
        for (int i = 0; i < 2; ++i) {
            const int pa = p0 + R[i], pb = p0 + R[i] + HALF;
            const int ta = pa < n ? (L[pa] >> 2) : 0, tb = pb < n ? (L[pb] >> 2) : 0;
            v0[i] = (unsigned)(ta * K + C[i]) * 2u; v1[i] = (unsigned)(tb * K + C[i]) * 2u;
        }
    }
};
struct ProbDown {
    static constexpr int K = 512, SCALE_A = 0x7c7c7c7c  , SCALE_B = 0x77777777  ;
    const bf16_t* H; const bf16_t* W; MoeTabs T;
    __device__ __forceinline__ const char* a_ptr(const Unit& u) const { return (const char*)H + (size_t)u.pm * BM * K * 2; }
    __device__ __forceinline__ const char* b_ptr(const Unit& u) const { const int e = T.tile_e[u.pm]; return (const char*)W + ((size_t)e * 1024 + (size_t)u.pn * BM) * K * 2; }
    __device__ __forceinline__ void a_voff(const Unit&, const int (&R)[2], const int (&C)[2], unsigned (&v0)[2], unsigned (&v1)[2]) const {
#pragma unroll
        for (int i = 0; i < 2; ++i) { v0[i] = (unsigned)(R[i] * K + C[i]) * 2u; v1[i] = (unsigned)((R[i] + HALF) * K + C[i]) * 2u; }
    }
};

typedef f32x4 Acc[2][2][4][2];
struct EpiProj {
    static constexpr bool PERM = true, HAS_MID = false; static constexpr int MID_T = -1;
    bf16_t *xp, *q, *k, *v, *gp, *ga; const float* rope;
    __device__ __forceinline__ void mid(Acc&, const Unit&, int, int, int, int) const {}
    __device__ __forceinline__ void operator()(const Acc& acc, const Unit& u, int wr, int wc, int fr, int fq) const {
        const int pn = u.pn; bf16_t* O; int ldc, ct; bool rot = false; float sc = 1.f;
        if (pn < 2) { O = xp; ldc = 512; ct = pn; } else if (pn < 5) { O = q; ldc = 768; ct = pn - 2; rot = true; sc = 0.125f; }
        else if (pn < 8) { O = k; ldc = 768; ct = pn - 5; rot = true; } else if (pn < 11) { O = v; ldc = 768; ct = pn - 8; }
        else if (pn < 15) { O = gp; ldc = 1024; ct = pn - 11; } else { O = ga; ldc = 1024; ct = pn - 15; }
        rot = rot && ((wc & 1) == 0);
        const int row0 = u.pm * BM + wr * 64 + fr, col0 = ct * BM + wc * 32 + 8 * fq;
        const float sgn = (fq == 0) ? -1.f : 1.f; const bool act = fq < 2;
#pragma unroll
        for (int ai = 0; ai < 2; ++ai)
#pragma unroll
            for (int m = 0; m < 4; ++m) {
                const int row = row0 + ai * HALF + m * 16;
                f32x4 c0 = {1.f, 1.f, 1.f, 1.f}, c1 = c0, s0 = {0.f, 0.f, 0.f, 0.f}, s1 = s0;
                if (rot) { const f32x4* rp = (const f32x4*)(rope + (size_t)row * 16); c0 = rp[0]; c1 = rp[1]; s0 = rp[2]; s1 = rp[3]; }
                bf16_t* rowp = O + (size_t)row * ldc + col0;
#pragma unroll
                for (int bj = 0; bj < 2; ++bj) {
                    f32x4 v0 = acc[ai][bj][m][0], v1 = acc[ai][bj][m][1];
                    if (rot) {
                        f32x4 p0, p1;
#pragma unroll
                        for (int j = 0; j < 4; ++j) { p0[j] = __shfl_xor(v0[j], 16); p1[j] = __shfl_xor(v1[j], 16); }
                        if (act) { v0 = v0 * c0 + (p0 * s0) * sgn; v1 = v1 * c1 + (p1 * s1) * sgn; }
                    }
                    v0 = v0 * sc; v1 = v1 * sc;
                    u32x4 w; w.x = cvt_pk_bf16(v0[0], v0[1]); w.y = cvt_pk_bf16(v0[2], v0[3]); w.z = cvt_pk_bf16(v1[0], v1[1]); w.w = cvt_pk_bf16(v1[2], v1[3]);
                    *(u32x4*)(rowp + bj * HALF) = w;
                }
            }
    }
};
struct EpiMerged {
    static constexpr bool PERM = true, HAS_MID = true; static constexpr int MID_T = 4;
    const bf16_t *gp, *ga; bf16_t* out;
    __device__ __forceinline__ void mid(Acc& acc, const Unit& u, int wr, int wc, int fr, int fq) const {
        int row0 = u.pm * BM + wr * 64 + fr; const int col0 = u.pn * BM + wc * 32 + 8 * fq;
        asm volatile("" : "+v"(row0));
#pragma unroll
        for (int ai = 0; ai < 2; ++ai)
#pragma unroll
            for (int m = 0; m < 4; ++m) {
                const size_t off = (size_t)(row0 + ai * HALF + m * 16) * D + col0;
#pragma unroll
                for (int bj = 0; bj < 2; ++bj) {
                    const u32x4 a = *(const u32x4*)(ga + off + bj * HALF), p = *(const u32x4*)(gp + off + bj * HALF);
                    f32x4 f0, f1;
#pragma unroll
                    for (int j = 0; j < 2; ++j) {
                        f0[2 * j] = fast_sigmoid(bflo(a[j])) * (1.f + __expf(-fmaxf(bflo(p[j]), -30.f)));
                        f0[2 * j + 1] = fast_sigmoid(bfhi(a[j])) * (1.f + __expf(-fmaxf(bfhi(p[j]), -30.f)));
                        f1[2 * j] = fast_sigmoid(bflo(a[2 + j])) * (1.f + __expf(-fmaxf(bflo(p[2 + j]), -30.f)));
                        f1[2 * j + 1] = fast_sigmoid(bfhi(a[2 + j])) * (1.f + __expf(-fmaxf(bfhi(p[2 + j]), -30.f)));
                    }
                    acc[ai][bj][m][0] *= f0; acc[ai][bj][m][1] *= f1;
                    asm volatile("" : "+v"(acc[ai][bj][m][0]), "+v"(acc[ai][bj][m][1]) :: "memory");
                }
            }
    }
    __device__ __forceinline__ void operator()(const Acc& acc, const Unit& u, int wr, int wc, int fr, int fq) const {
        const int row0 = u.pm * BM + wr * 64 + fr, col0 = u.pn * BM + wc * 32 + 8 * fq;
#pragma unroll
        for (int ai = 0; ai < 2; ++ai)
#pragma unroll
            for (int m = 0; m < 4; ++m) {
                const size_t off = (size_t)(row0 + ai * HALF + m * 16) * D + col0;
#pragma unroll
                for (int bj = 0; bj < 2; ++bj) {
                    const u32x4 p = *(const u32x4*)(gp + off + bj * HALF);
                    f32x4 v0 = acc[ai][bj][m][0], v1 = acc[ai][bj][m][1];
#pragma unroll
                    for (int j = 0; j < 2; ++j) {
                        v0[2 * j] *= fast_sigmoid(fmaxf(bflo(p[j]), -30.f)); v0[2 * j + 1] *= fast_sigmoid(fmaxf(bfhi(p[j]), -30.f));
                        v1[2 * j] *= fast_sigmoid(fmaxf(bflo(p[2 + j]), -30.f)); v1[2 * j + 1] *= fast_sigmoid(fmaxf(bfhi(p[2 + j]), -30.f));
                    }
                    u32x4 w; w.x = cvt_pk_bf16(v0[0], v0[1]); w.y = cvt_pk_bf16(v0[2], v0[3]); w.z = cvt_pk_bf16(v1[0], v1[1]); w.w = cvt_pk_bf16(v1[2], v1[3]);
                    *(u32x4*)(out + off + bj * HALF) = w;
                }
                asm volatile("" ::: "memory");
            }
    }
};
struct EpiWo {
    static constexpr bool PERM = false, HAS_MID = false; static constexpr int MID_T = -1;
    const float *x, *ada; float* y;
    __device__ __forceinline__ void mid(Acc&, const Unit&, int, int, int, int) const {}
    __device__ __forceinline__ void operator()(const Acc& acc, const Unit& u, int wr, int wc, int fr, int fq) const {
        const int row0 = u.pm * BM + wr * 64 + fr, col0 = u.pn * BM + wc * 32 + 4 * fq;
        const float* gate = ada + ((u.pm * BM) / S) * 6 * D + 2 * D;
        f32x4 gv[2][2];
#pragma unroll
        for (int bj = 0; bj < 2; ++bj)
#pragma unroll
            for (int n = 0; n < 2; ++n) gv[bj][n] = *(const f32x4*)(gate + col0 + bj * HALF + n * 16) + 1.0f;
#pragma unroll
        for (int ai = 0; ai < 2; ++ai)
#pragma unroll
            for (int m = 0; m < 4; ++m) {
                const size_t off = (size_t)(row0 + ai * HALF + m * 16) * D + col0;
#pragma unroll
                for (int bj = 0; bj < 2; ++bj)
#pragma unroll
                    for (int n = 0; n < 2; ++n) {
                        const f32x4 xv = *(const f32x4*)(x + off + bj * HALF + n * 16);
                        *(f32x4*)(y + off + bj * HALF + n * 16) = xv * DN_ALPHA + gv[bj][n] * acc[ai][bj][m][n];
                    }
            }
    }
};
struct EpiGU {
    static constexpr bool PERM = true, HAS_MID = false; static constexpr int MID_T = -1;
    const float *bg, *bu; bf16_t* H; MoeTabs T;
    __device__ __forceinline__ void mid(Acc&, const Unit&, int, int, int, int) const {}
    __device__ __forceinline__ void operator()(const Acc& acc, const Unit& u, int wr, int wc, int fr, int fq) const {
        const int e = T.tile_e[u.pm], col0 = u.pn * HALF + wc * 32 + 8 * fq, row0 = u.pm * BM + wr * 64 + fr;
        const float dsc = FP8_PLAIN ? (1.0f / 2048.0f) : 1.0f;
        const f32x4 bg0 = *(const f32x4*)(bg + e * 1024 + col0), bg1 = *(const f32x4*)(bg + e * 1024 + col0 + 4);
        const f32x4 bu0 = *(const f32x4*)(bu + e * 1024 + col0), bu1 = *(const f32x4*)(bu + e * 1024 + col0 + 4);
#pragma unroll
        for (int ai = 0; ai < 2; ++ai)
#pragma unroll
            for (int m = 0; m < 4; ++m) {
                f32x4 g0 = acc[ai][0][m][0] * dsc + bg0, g1 = acc[ai][0][m][1] * dsc + bg1, u0 = acc[ai][1][m][0] * dsc, u1 = acc[ai][1][m][1] * dsc;
                f32x4 h0, h1;
#pragma unroll
                for (int j = 0; j < 4; ++j) {
                    const float ga = fminf(g0[j], SW_LIMIT), gb = fminf(g1[j], SW_LIMIT);
                    const float ua = fminf(fmaxf(u0[j] + bu0[j], -SW_LIMIT), SW_LIMIT) + 1.0f, ub = fminf(fmaxf(u1[j] + bu1[j], -SW_LIMIT), SW_LIMIT) + 1.0f;
                    h0[j] = ga * fast_sigmoid(SW_ALPHA * ga) * ua; h1[j] = gb * fast_sigmoid(SW_ALPHA * gb) * ub;
                }
                h0 = h0 * SC_H; h1 = h1 * SC_H;
                u32x2 w; w.x = (unsigned)cvt4_fp8(h0[0], h0[1], h0[2], h0[3]); w.y = (unsigned)cvt4_fp8(h1[0], h1[1], h1[2], h1[3]);
                *(u32x2*)((unsigned char*)H + (size_t)(row0 + ai * HALF + m * 16) * 1024 + col0) = w;
            }
    }
};
struct EpiDown {
    static constexpr bool PERM = true, HAS_MID = false; static constexpr int MID_T = -1;
    const float *bd, *listw; const int* list; bf16_t* YB; MoeTabs T;
    __device__ __forceinline__ void mid(Acc&, const Unit&, int, int, int, int) const {}
    __device__ __forceinline__ void operator()(const Acc& acc, const Unit& u, int wr, int wc, int fr, int fq) const {
        const int e = T.tile_e[u.pm], p0 = (u.pm - T.tile0[e]) * BM + wr * 64 + fr, n = T.cnt[e], col0 = u.pn * BM + wc * 32 + 8 * fq;
        f32x4 b[2][2];
#pragma unroll
        for (int bj = 0; bj < 2; ++bj) { b[bj][0] = *(const f32x4*)(bd + e * 1024 + col0 + bj * HALF); b[bj][1] = *(const f32x4*)(bd + e * 1024 + col0 + bj * HALF + 4); }
#pragma unroll
        for (int ai = 0; ai < 2; ++ai)
#pragma unroll
            for (int m = 0; m < 4; ++m) {
                const int pos = p0 + ai * HALF + m * 16;
                if (pos < n) {
                    const int slot = list[(size_t)e * NTOK + pos]; const float w = listw[(size_t)e * NTOK + pos];
#pragma unroll
                    for (int bj = 0; bj < 2; ++bj) {
                        const float dsc = FP8_PLAIN ? (1.0f / 2048.0f) : 1.0f;
                        const f32x4 v0 = (acc[ai][bj][m][0] * dsc + b[bj][0]) * w, v1 = (acc[ai][bj][m][1] * dsc + b[bj][1]) * w;
                        u32x4 o; o.x = cvt_pk_bf16(v0[0], v0[1]); o.y = cvt_pk_bf16(v0[2], v0[3]); o.z = cvt_pk_bf16(v1[0], v1[1]); o.w = cvt_pk_bf16(v1[2], v1[3]);
                        *(u32x4*)(YB + (size_t)slot * 1024 + col0 + bj * HALF) = o;
                    }
                }
            }
    }
};
}

struct Args { const void* in[23]; float* out; unsigned char* ws; int ph_lo, ph_hi; };
struct Frame {
    LAS unsigned char* lds; int tid, lane, wave, vcu, G;
    const float *x, *c, *w_ada, *b_ada, *w_in, *pool_w, *pool_scale, *w_pool_out, *w_attn_out, *w_o, *ln1_g, *ln1_b, *w_router, *b_router;
    const float *w_gate, *b_gate, *w_up, *b_up, *w_down, *b_down, *ln2_g, *ln2_b; const int* positions;
    float* out; unsigned char* ws;
};
__device__ __forceinline__ float wsum(float v) {
#pragma unroll
    for (int o = 1; o < 64; o <<= 1) v += __shfl_xor(v, o);
    return v;
}
__device__ __forceinline__ unsigned pk2(float lo, float hi) { return (unsigned)f2bf(lo) | ((unsigned)f2bf(hi) << 16); }

__device__ __forceinline__ void p0_transpose_item(const float* W, int K, int N, bf16_t* WT, int dld, int koff, int mode, LAS float* scr, int item, int lane) {
    const int nblk = N / 32, kb = item / nblk, nb = item % nblk, k0 = 64 * kb, n0 = 32 * nb;
#pragma unroll 8
    for (int i = 0; i < 32; ++i) { const int kk = 2 * i + (lane >> 5); scr[kk * 33 + (lane & 31)] = W[(size_t)(k0 + kk) * N + n0 + (lane & 31)]; }
    LDS_WAIT(); asm volatile("" ::: "memory");
    const int c = lane & 7;
#pragma unroll
    for (int j = 0; j < 4; ++j) { const int n = (lane >> 3) + 8 * j; const LAS float* s = scr + (8 * c) * 33 + n;
        u32x4 o; o.x = pk2(s[0 * 33], s[1 * 33]); o.y = pk2(s[2 * 33], s[3 * 33]); o.z = pk2(s[4 * 33], s[5 * 33]); o.w = pk2(s[6 * 33], s[7 * 33]);
        *(GAS u32x4*)(WT + (size_t)rowmap(n0 + n, mode) * dld + koff + k0 + 8 * c) = o; }
    LDS_WAIT(); asm volatile("" ::: "memory");
}
__device__ __forceinline__ void p0_transpose_item_fp8(const float* W, int K, int N, unsigned char* WT, int mode, LAS float* scr, int item, int lane) {
    const int nblk = N / 32, kb = item / nblk, nb = item % nblk, k0 = 128 * kb, n0 = 32 * nb;
#pragma unroll 8
    for (int i = 0; i < 64; ++i) { const int kk = 2 * i + (lane >> 5); scr[kk * 33 + (lane & 31)] = W[(size_t)(k0 + kk) * N + n0 + (lane & 31)]; }
    LDS_WAIT(); asm volatile("" ::: "memory");
    const int c = lane & 7;
#pragma unroll
    for (int j = 0; j < 4; ++j) { const int n = (lane >> 3) + 8 * j; const LAS float* s = scr + (16 * c) * 33 + n;
        u32x4 o;
#pragma unroll
        for (int q = 0; q < 4; ++q) o[q] = (unsigned)cvt4_fp8(s[(4 * q) * 33] * SC_W, s[(4 * q + 1) * 33] * SC_W, s[(4 * q + 2) * 33] * SC_W, s[(4 * q + 3) * 33] * SC_W);
        *(GAS u32x4*)(WT + (size_t)rowmap(n0 + n, mode) * K + k0 + 16 * c) = o; }
    LDS_WAIT(); asm volatile("" ::: "memory");
}
__device__ __forceinline__ void p0_prologue(Frame& F) {
    unsigned char* ws = F.ws;
    bf16_t *wt_in = (bf16_t*)(ws + WS_WIN), *wt_pool = (bf16_t*)(ws + WS_WPOOL), *wt_cat = (bf16_t*)(ws + WS_WCAT), *wt_o = (bf16_t*)(ws + WS_WO), *wt_o2_unused = nullptr; unsigned char *wt_dn = ws + WS_WDN, *wt_gu = ws + WS_WGU; (void)wt_o2_unused;
    float* ada = (float*)(ws + WS_ADA); float* rope = (float*)(ws + WS_ROPE);
    for (int item = blockIdx.x; item < 256; item += F.G) {
        const int j0 = 24 * item;
        float a0[24], a1[24];
#pragma unroll
        for (int i = 0; i < 24; ++i) { a0[i] = 0.f; a1[i] = 0.f; }
#pragma unroll
        for (int kk = 0; kk < 2; ++kk) {
            const int k = 128 * F.wave + 2 * F.lane + kk;
            const float c0 = F.c[k], c1 = F.c[D + k]; const float s0 = c0 / (1.f + __expf(-c0)), s1 = c1 / (1.f + __expf(-c1));
            const f32x4* wp = (const f32x4*)(F.w_ada + (size_t)k * (6 * D) + j0);
#pragma unroll
            for (int i = 0; i < 6; ++i) { const f32x4 w = wp[i];
#pragma unroll
                for (int q = 0; q < 4; ++q) { a0[4 * i + q] += s0 * w[q]; a1[4 * i + q] += s1 * w[q]; } }
        }
        LAS float* red = (LAS float*)(F.lds);
#pragma unroll
        for (int i = 0; i < 24; ++i) { a0[i] = wsum(a0[i]); a1[i] = wsum(a1[i]); }
        if (F.lane == 0) {
#pragma unroll
            for (int i = 0; i < 24; ++i) { red[F.wave * 48 + i] = a0[i]; red[F.wave * 48 + 24 + i] = a1[i]; }
        }
        __syncthreads();
        if (F.tid < 48) { float s = 0.f;
#pragma unroll
            for (int w = 0; w < 8; ++w) s += red[w * 48 + F.tid];
            const int b = F.tid / 24, j = j0 + F.tid % 24; ada[b * 6 * D + j] = s + F.b_ada[j]; }
        __syncthreads();
    }
    for (int i = blockIdx.x * 512 + F.tid; i < NTOK * 8; i += F.G * 512) {
        const int tok = i >> 3, f = i & 7; const float ang = (float)F.positions[tok] * c_invfreq[f];
        rope[tok * 16 + f] = cosf(ang); rope[tok * 16 + 8 + f] = sinf(ang);
    }
    LAS float* scr = (LAS float*)(F.lds + F.wave * 16896);
    const int gw = F.vcu * NWAVES + F.wave, NGW = F.G * NWAVES;
    constexpr int I_IN = (D / 64) * (INW / 32), I_PW = 4 * 2 * 4, I_AO = (AOW / 64) * (D / 32), I_PO = (POOLW / 64) * (D / 32), I_O = (D / 64) * (D / 32), I_E8 = (D / 128) * (D / 32), I_E = NE * I_E8;
    constexpr int NITEMS = I_IN + I_PW + I_AO + I_PO + I_O + 3 * I_E;
    for (int it = gw; it < NITEMS; it += NGW) {
        int r = it;
        if (r < I_IN) { p0_transpose_item(F.w_in, D, INW, wt_in, D, 0, 0, scr, r, F.lane); continue; } r -= I_IN;
        if (r < I_PW) { const int g = r >> 3; p0_transpose_item(F.pool_w + g * 128 * 128, 128, 128, wt_pool + g * 128 * 128, 128, 0, 0, scr, r & 7, F.lane); continue; } r -= I_PW;
        if (r < I_AO) { p0_transpose_item(F.w_attn_out, AOW, D, wt_cat, 768, 0, 0, scr, r, F.lane); continue; } r -= I_AO;
        if (r < I_PO) { p0_transpose_item(F.w_pool_out, POOLW, D, wt_cat, 768, 256, 0, scr, r, F.lane); continue; } r -= I_PO;
        if (r < I_O) { p0_transpose_item(F.w_o, D, D, wt_o, D, 0, 0, scr, r, F.lane); continue; } r -= I_O;
        if (r < I_E) { const int e = r / I_E8; p0_transpose_item_fp8(F.w_gate + (size_t)e * D * D, D, D, wt_gu + (size_t)e * 2048 * D, 1, scr, r % I_E8, F.lane); continue; } r -= I_E;
        if (r < I_E) { const int e = r / I_E8; p0_transpose_item_fp8(F.w_up + (size_t)e * D * D, D, D, wt_gu + (size_t)e * 2048 * D, 2, scr, r % I_E8, F.lane); continue; } r -= I_E;
        { const int e = r / I_E8; p0_transpose_item_fp8(F.w_down + (size_t)e * D * D, D, D, wt_dn + (size_t)e * D * D, 0, scr, r % I_E8, F.lane); }
    }
}
__device__ __forceinline__ void p1_lnmod(Frame& F) {
    const float* ada = (const float*)(F.ws + WS_ADA); bf16_t* U = (bf16_t*)(F.ws + WS_U);
    const int gw = F.vcu * NWAVES + F.wave, NGW = F.G * NWAVES;
    f32x4 nv[4];
    if (gw < NTOK) { const GAS f32x4* xr = (const GAS f32x4*)(F.x + (size_t)gw * D) + F.lane;
#pragma unroll
        for (int j = 0; j < 4; ++j) nv[j] = xr[64 * j]; }
    for (int row = gw; row < NTOK; row += NGW) {
        f32x4 v[4]; float s = 0.f, s2 = 0.f;
#pragma unroll
        for (int j = 0; j < 4; ++j) v[j] = nv[j];
        if (row + NGW < NTOK) { const GAS f32x4* xr = (const GAS f32x4*)(F.x + (size_t)(row + NGW) * D) + F.lane;
#pragma unroll
            for (int j = 0; j < 4; ++j) nv[j] = xr[64 * j]; }
#pragma unroll
        for (int j = 0; j < 4; ++j) s += (v[j].x + v[j].y) + (v[j].z + v[j].w);
        const float mean = wsum(s) * (1.f / D);
#pragma unroll
        for (int j = 0; j < 4; ++j) { v[j] = v[j] - mean; s2 += (v[j].x * v[j].x + v[j].y * v[j].y) + (v[j].z * v[j].z + v[j].w * v[j].w); }
        const float rstd = rsqrtf(wsum(s2) * (1.f / D) + LN_EPS);
        const f32x4* sh = (const f32x4*)(ada + (row / S) * 6 * D) + F.lane; const f32x4* sc = (const f32x4*)(ada + (row / S) * 6 * D + D) + F.lane;
        GAS u32x2* o8 = (GAS u32x2*)(U + (size_t)row * D) + F.lane;
#pragma unroll
        for (int j = 0; j < 4; ++j) { const f32x4 y = v[j] * rstd * (sc[64 * j] + 1.0f) + sh[64 * j]; u32x2 w; w.x = cvt_pk_bf16(y.x, y.y); w.y = cvt_pk_bf16(y.z, y.w); o8[64 * j] = w; }
    }
}
__device__ __forceinline__ void glds16(const void* gsrc, unsigned lds_dst) { unsigned keep;
    asm volatile("s_mov_b32 %0, m0\n\ts_mov_b32 m0, %2\n\ts_nop 0\n\tglobal_load_lds_dwordx4 %1, off\n\ts_mov_b32 m0, %0" : "=&s"(keep) : "v"(gsrc), "s"(lds_dst) : "memory"); }
typedef short v4i16_t __attribute__((ext_vector_type(4)));
__device__ __forceinline__ s16x4 vtr(const LAS unsigned char* p) { return __builtin_bit_cast(s16x4, __builtin_amdgcn_ds_read_tr16_b64_v4i16((LAS v4i16_t*)p)); }

struct AttnDesc { int b, h, c, n, dl; };
__device__ __forceinline__ AttnDesc attn_decode(int uid) {
    AttnDesc d; d.b = uid / 768; const int rem = uid % 768; d.h = rem >> 6; const int x = rem & 63, g = d.h >> 2;
    d.dl = 1 << (2 * g); const int nb = 64 >> (2 * g); d.c = x / nb; d.n = x % nb; return d;
}
__device__ __forceinline__ void attn_issue(const Frame& F, int uid, int set) {
    const AttnDesc d = attn_decode(uid);
    const char* Qb = (const char*)(F.ws + WS_Q); const char* Kb = (const char*)(F.ws + WS_K); const char* Vb = (const char*)(F.ws + WS_V);
    const unsigned lds0 = (unsigned)(uintptr_t)F.lds, ldsK = lds0 + (unsigned)set * 65536u, ldsV = ldsK + 32768u;
    const int sub = F.lane >> 3, slot = F.lane & 7;
    const size_t hb = (size_t)d.h * 128;
#pragma unroll
    for (int pi = 0; pi < 4; ++pi) {
        const int p = 4 * F.wave + pi, key = 8 * p + sub, chunk = slot ^ (key & 7);
        const int jk = d.n > 0 ? 128 * (d.n - 1) + key : (key & 127);
        const size_t off = ((size_t)(d.b * S + d.c + d.dl * jk)) * (AW * 2) + hb + chunk * 16;
        glds16(Kb + off, (unsigned)__builtin_amdgcn_readfirstlane(ldsK + p * 1024));
        glds16(Vb + off, (unsigned)__builtin_amdgcn_readfirstlane(ldsV + p * 1024));
    }
#pragma unroll
    for (int qp = 0; qp < 2; ++qp) {
        const int qrow = 8 * qp + sub, chunk = slot ^ (qrow & 7);
        const size_t off = ((size_t)(d.b * S + d.c + d.dl * (128 * d.n + 16 * F.wave + qrow))) * (AW * 2) + hb + chunk * 16;
        glds16(Qb + off, (unsigned)__builtin_amdgcn_readfirstlane(lds0 + QREG_OFF + F.wave * 2048 + qp * 1024));
    }
}
__device__ __forceinline__ void attn_compute(const Frame& F, int uid, int set, bf16x8 qf0, bf16x8 qf1) {
    const AttnDesc d = attn_decode(uid);
    const int fr = F.lane & 15, fq = F.lane >> 4, w = F.wave;
    const unsigned ldsK = (unsigned)set * 65536u, ldsV = ldsK + 32768u;
    f32x4 st[9];
#pragma unroll
    for (int t = 0; t < 9; ++t) {
        const int key = 16 * (w + t) + fr;
        const LAS unsigned char* kp = F.lds + ldsK + key * 128;
        const bf16x8 k0 = *(const LAS bf16x8*)(kp + ((fq ^ (key & 7)) << 4)), k1 = *(const LAS bf16x8*)(kp + (((fq + 4) ^ (key & 7)) << 4));
        f32x4 a = {0.f, 0.f, 0.f, 0.f};
        a = __builtin_amdgcn_mfma_f32_16x16x32_bf16(k0, qf0, a, 0, 0, 0);
        a = __builtin_amdgcn_mfma_f32_16x16x32_bf16(k1, qf1, a, 0, 0, 0);
        st[t] = a;
    }
    const float NEG = -1e30f;
#pragma unroll
    for (int r = 0; r < 4; ++r) { if (4 * fq + r < fr) st[0][r] = NEG; if (4 * fq + r > fr) st[8][r] = NEG; }
    if (d.n == 0) {
#pragma unroll
        for (int t = 0; t < 8; ++t) if (w + t < 8) st[t] = (f32x4){NEG, NEG, NEG, NEG};
    }
    float m = NEG;
#pragma unroll
    for (int t = 0; t < 9; ++t) m = fmaxf(m, fmaxf(fmaxf(st[t][0], st[t][1]), fmaxf(st[t][2], st[t][3])));
    m = fmaxf(m, __shfl_xor(m, 16)); m = fmaxf(m, __shfl_xor(m, 32));
    float den = 0.f;
#pragma unroll
    for (int t = 0; t < 9; ++t) {
#pragma unroll
        for (int r = 0; r < 4; ++r) { const float p = __expf(st[t][r] - m); st[t][r] = p; den += p; }
    }
    den += __shfl_xor(den, 16); den += __shfl_xor(den, 32);
    f32x4 o[4];
#pragma unroll
    for (int dt = 0; dt < 4; ++dt) o[dt] = (f32x4){0.f, 0.f, 0.f, 0.f};
    const int q4 = fr >> 2, p4 = fr & 3;
#pragma unroll
    for (int j = 0; j < 5; ++j) {
        const int t0 = 2 * j, t1 = (2 * j + 1 < 9) ? 2 * j + 1 : 2 * j;
        bf16x8 pb;
        { const f32x4 sa = st[t0]; f32x4 sb = {0.f, 0.f, 0.f, 0.f}; if (2 * j + 1 < 9) sb = st[t1];
          const u32x4 pw = {cvt_pk_bf16(sa[0], sa[1]), cvt_pk_bf16(sa[2], sa[3]), cvt_pk_bf16(sb[0], sb[1]), cvt_pk_bf16(sb[2], sb[3])}; pb = __builtin_bit_cast(bf16x8, pw); }
        const int key0 = 16 * (w + t0) + 4 * fq + q4, key1 = 16 * (w + t1) + 4 * fq + q4;
#pragma unroll
        for (int dt = 0; dt < 4; ++dt) {
            const int ch = 2 * dt + (p4 >> 1);
            const s16x4 lo = vtr(F.lds + ldsV + key0 * 128 + ((ch ^ (key0 & 7)) << 4) + 8 * (p4 & 1));
            const s16x4 hi = vtr(F.lds + ldsV + key1 * 128 + ((ch ^ (key1 & 7)) << 4) + 8 * (p4 & 1));
            const bf16x8 va = {lo[0], lo[1], lo[2], lo[3], hi[0], hi[1], hi[2], hi[3]};
            o[dt] = __builtin_amdgcn_mfma_f32_16x16x32_bf16(va, pb, o[dt], 0, 0, 0);
        }
    }
    const float inv = 1.0f / den;
    const size_t tq = (size_t)(d.b * S + d.c + d.dl * (128 * d.n + 16 * w + fr));
    bf16_t* OG = (bf16_t*)(F.ws + WS_OG) + tq * AW + d.h * 64 + 4 * fq;
#pragma unroll
    for (int dt = 0; dt < 4; ++dt) { u32x2 wv; wv.x = cvt_pk_bf16(o[dt][0] * inv, o[dt][1] * inv); wv.y = cvt_pk_bf16(o[dt][2] * inv, o[dt][3] * inv); *(u32x2*)(OG + 16 * dt) = wv; }
    if (fq == 0) ((float*)(F.ws + WS_LSE))[tq * NH + d.h] = m + __logf(den);
}
__device__ __forceinline__ void p3_attention(Frame& F) {
    constexpr int NUNITS = NB * NH * 64;
    int i = 0, uid = F.vcu;
    if (uid < NUNITS) attn_issue(F, uid, 0);
    for (; uid < NUNITS; uid += F.G, ++i) {
        asm volatile("s_waitcnt vmcnt(0)" ::: "memory");
        __builtin_amdgcn_s_barrier();
        asm volatile("" ::: "memory");
        const int fr = F.lane & 15, fq = F.lane >> 4;
        const LAS unsigned char* qp = F.lds + QREG_OFF + F.wave * 2048 + fr * 128;
        const bf16x8 qf0 = *(const LAS bf16x8*)(qp + ((fq ^ (fr & 7)) << 4)), qf1 = *(const LAS bf16x8*)(qp + (((fq + 4) ^ (fr & 7)) << 4));
        asm volatile("s_waitcnt lgkmcnt(0)" ::: "memory");
        __builtin_amdgcn_sched_barrier(0);
        if (uid + F.G < NUNITS) attn_issue(F, uid + F.G, (i + 1) & 1);
        attn_compute(F, uid, i & 1, qf0, qf1);
    }
    asm volatile("s_waitcnt vmcnt(0)" ::: "memory");
    __builtin_amdgcn_s_barrier();
}
template <int W> __device__ __forceinline__ void pool_unit(const Frame& F, int g, int tok0) {
    const bf16_t* XP = (const bf16_t*)(F.ws + WS_XP); const bf16_t* WP = (const bf16_t*)(F.ws + WS_WPOOL); bf16_t* ACAT = (bf16_t*)(F.ws + WS_ACAT);
    int fr = F.lane & 15; const int fq = F.lane >> 4;
    asm volatile("" : "+v"(fr));
    const int tok = tok0 + fr, t = tok % S;
    const int cnt = (t + 1 < W) ? t + 1 : W; const float rc = 1.0f / (float)cnt;
    bf16x8 mb[4];
#pragma unroll
    for (int ks = 0; ks < 4; ++ks) {
        const bf16_t* base = XP + (size_t)tok * POOLW + g * 128 + 32 * ks + 8 * fq;
        u32x4 pv[W];
#pragma unroll
        for (int j = 0; j < W; ++j) { const int jj = j < cnt ? j : 0; pv[j] = *(const u32x4*)(base - (size_t)jj * POOLW); }
        float s[8];
#pragma unroll
        for (int q = 0; q < 8; ++q) s[q] = 0.f;
#pragma unroll
        for (int j = 0; j < W; ++j) { const float mk = j < cnt ? 1.f : 0.f;
#pragma unroll
            for (int q = 0; q < 4; ++q) { s[2 * q] += mk * bflo(pv[j][q]); s[2 * q + 1] += mk * bfhi(pv[j][q]); } }
        u32x4 mw;
#pragma unroll
        for (int q = 0; q < 4; ++q) mw[q] = cvt_pk_bf16(s[2 * q] * rc - bflo(pv[0][q]), s[2 * q + 1] * rc - bfhi(pv[0][q]));
        mb[ks] = __builtin_bit_cast(bf16x8, mw);
        asm volatile("" ::: "memory");
    }
#pragma unroll
    for (int nt = 0; nt < 8; ++nt) {
        if ((nt & 1) == 0) asm volatile("" ::: "memory");
        f32x4 a = {0.f, 0.f, 0.f, 0.f};
#pragma unroll
        for (int ks = 0; ks < 4; ++ks) {
            const bf16x8 wa = *(const bf16x8*)(WP + (size_t)g * 128 * 128 + (size_t)(16 * nt + fr) * 128 + 32 * ks + 8 * fq);
            a = __builtin_amdgcn_mfma_f32_16x16x32_bf16(wa, mb[ks], a, 0, 0, 0);
        }
        const f32x4 sc = *(const f32x4*)(F.pool_scale + g * 128 + 16 * nt + 4 * fq);
        u32x2 wv; wv.x = cvt_pk_bf16(a[0] * sc[0], a[1] * sc[1]); wv.y = cvt_pk_bf16(a[2] * sc[2], a[3] * sc[3]);
        *(u32x2*)(ACAT + (size_t)tok * 768 + 256 + g * 128 + 16 * nt + 4 * fq) = wv;
    }
}
__device__ __forceinline__ void p3_pool(Frame& F) {
    const int gw = F.vcu * NWAVES + F.wave, NGW = F.G * NWAVES;
    for (int u = gw; u < NTOK / 8; u += NGW) {
        const int tok0 = (u >> 1) * 16;
        if (u & 1) { pool_unit<4>(F, 1, tok0); pool_unit<8>(F, 2, tok0); } else { pool_unit<2>(F, 0, tok0); pool_unit<16>(F, 3, tok0); }
    }
}
__device__ __forceinline__ void p4_merge(Frame& F) {
    const bf16_t* OG = (const bf16_t*)(F.ws + WS_OG); const float* LSE = (const float*)(F.ws + WS_LSE); bf16_t* ACAT = (bf16_t*)(F.ws + WS_ACAT);
    const int stride = F.G * 512;
    for (int i0 = F.vcu * 512 + F.tid; i0 < NTOK * 32; i0 += 4 * stride) {
        u32x4 a[4], bb[4], c[4]; float l0[4], l1[4], l2[4];
#pragma unroll
        for (int u = 0; u < 4; ++u) { const int i = i0 + u * stride < NTOK * 32 ? i0 + u * stride : i0; const int ch = i & 7, hs = (i >> 3) & 3, tok = i >> 5;
            l0[u] = LSE[tok * NH + hs]; l1[u] = LSE[tok * NH + 4 + hs]; l2[u] = LSE[tok * NH + 8 + hs];
            const bf16_t* p = OG + (size_t)tok * AW + hs * 64 + ch * 8; a[u] = *(const u32x4*)p; bb[u] = *(const u32x4*)(p + 256); c[u] = *(const u32x4*)(p + 512); }
#pragma unroll
        for (int u = 0; u < 4; ++u) { const int i = i0 + u * stride; if (i < NTOK * 32) { const int ch = i & 7, hs = (i >> 3) & 3, tok = i >> 5;
            const float mx = fmaxf(l0[u], fmaxf(l1[u], l2[u])); float w0 = __expf(l0[u] - mx), w1 = __expf(l1[u] - mx), w2 = __expf(l2[u] - mx); const float inv = 1.f / (w0 + w1 + w2);
            w0 *= inv; w1 *= inv; w2 *= inv; u32x4 o;
#pragma unroll
            for (int q = 0; q < 4; ++q) o[q] = cvt_pk_bf16(w0 * bflo(a[u][q]) + w1 * bflo(bb[u][q]) + w2 * bflo(c[u][q]), w0 * bfhi(a[u][q]) + w1 * bfhi(bb[u][q]) + w2 * bfhi(c[u][q]));
            *(u32x4*)(ACAT + (size_t)tok * 768 + hs * 64 + ch * 8) = o; } }
    }
}
__device__ __forceinline__ unsigned fkey(float x, int e) { unsigned u = __float_as_uint(x); u = (u & 0x80000000u) ? ~u : (u | 0x80000000u); return (u & 0xFFFFFFE0u) | (unsigned)(31 - e); }
__device__ __forceinline__ void p7_router(Frame& F) {
    const float* ada = (const float*)(F.ws + WS_ADA); unsigned char* U8 = F.ws + WS_U8;
    int* cnt = (int*)(F.ws + WS_CTL) + CW_CNT; int* list = (int*)(F.ws + WS_LIST); float* listw = (float*)(F.ws + WS_LISTW);
    LAS int* lcnt = (LAS int*)(F.lds + TAB_OFF + T_LCNT); LAS int* gbase = (LAS int*)(F.lds + TAB_OFF + T_GBASE); LAS int* rec = (LAS int*)(F.lds + TAB_OFF + T_REC);
    for (int i = F.tid; i < D * 8; i += 512) { const int c = i >> 3, s = i & 7; const f32x4 w = *(const f32x4*)(F.w_router + (size_t)c * NE + s * 4);
        *(LAS f32x4*)(F.lds + ((c & 3) * 256 + (c >> 2)) * 144 + s * 16) = w; }
    for (int tile = blockIdx.x; tile < NTOK / 64; tile += F.G) {
        if (F.tid < 32) lcnt[F.tid] = 0;
        __syncthreads();
        for (int rp = 0; rp < 4; ++rp) {
            const int rl = F.wave * 8 + 2 * rp, row = tile * 64 + rl, b = row / S;
            int ln = F.lane; asm volatile("" : "+v"(ln));
            const int eidx = ((ln & 1) << 4) | (ln >> 2);
            f32x4 v[2][4];
#pragma unroll
            for (int r = 0; r < 2; ++r) { const GAS f32x4* yr = (const GAS f32x4*)(F.out + (size_t)(row + r) * D) + ln;
#pragma unroll
                for (int j = 0; j < 4; ++j) v[r][j] = yr[64 * j]; }
            const f32x4* sh = (const f32x4*)(ada + b * 6 * D + 3 * D) + ln; const f32x4* sc = (const f32x4*)(ada + b * 6 * D + 4 * D) + ln;
#pragma unroll
            for (int r = 0; r < 2; ++r) {
                GAS f32x4* yw = (GAS f32x4*)(F.out + (size_t)(row + r) * D) + ln;
                float s = 0.f, s2 = 0.f;
#pragma unroll
                for (int j = 0; j < 4; ++j) s += (v[r][j].x + v[r][j].y) + (v[r][j].z + v[r][j].w);
                float mean = wsum(s) * (1.f / D);
#pragma unroll
                for (int j = 0; j < 4; ++j) { v[r][j] = v[r][j] - mean; s2 += (v[r][j].x * v[r][j].x + v[r][j].y * v[r][j].y) + (v[r][j].z * v[r][j].z + v[r][j].w * v[r][j].w); }
                float rstd = rsqrtf(wsum(s2) * (1.f / D) + LN_EPS);
                s = 0.f;
#pragma unroll
                for (int j = 0; j < 4; ++j) { const f32x4 g = ((const f32x4*)F.ln1_g)[ln + 64 * j], bb = ((const f32x4*)F.ln1_b)[ln + 64 * j];
                    v[r][j] = v[r][j] * rstd * g + bb; yw[64 * j] = v[r][j]; s += (v[r][j].x + v[r][j].y) + (v[r][j].z + v[r][j].w); }
                mean = wsum(s) * (1.f / D); s2 = 0.f;
#pragma unroll
                for (int j = 0; j < 4; ++j) { v[r][j] = v[r][j] - mean; s2 += (v[r][j].x * v[r][j].x + v[r][j].y * v[r][j].y) + (v[r][j].z * v[r][j].z + v[r][j].w * v[r][j].w); }
                rstd = rsqrtf(wsum(s2) * (1.f / D) + LN_EPS);
                GAS unsigned* o4 = (GAS unsigned*)(U8 + (size_t)(row + r) * D) + ln;
#pragma unroll
                for (int j = 0; j < 4; ++j) { v[r][j] = v[r][j] * rstd * (sc[64 * j] + 1.0f) + sh[64 * j];
                    o4[64 * j] = (unsigned)cvt4_fp8(v[r][j].x * SC_U, v[r][j].y * SC_U, v[r][j].z * SC_U, v[r][j].w * SC_U); }
            }
            float lgt[2];
            {
                const bool b5 = ln & 32, b4 = ln & 16, b3 = ln & 8, b2 = ln & 4;
                float th[2][2];
#pragma unroll
                for (int h = 0; h < 2; ++h) {
                    float a0[16], a1[16];
#pragma unroll
                    for (int e = 0; e < 16; ++e) { a0[e] = 0.f; a1[e] = 0.f; }
#pragma unroll
                    for (int j = 0; j < 4; ++j) {
#pragma unroll
                        for (int q = 0; q < 4; ++q) {
                            const LAS f32x4* wp = (const LAS f32x4*)(F.lds + (q * 256 + ln + 64 * j) * 144 + h * 64);
                            const float u0 = v[0][j][q], u1 = v[1][j][q];
#pragma unroll
                            for (int s4 = 0; s4 < 4; ++s4) { const f32x4 w = wp[s4];
                                a0[4 * s4] += u0 * w.x; a0[4 * s4 + 1] += u0 * w.y; a0[4 * s4 + 2] += u0 * w.z; a0[4 * s4 + 3] += u0 * w.w;
                                a1[4 * s4] += u1 * w.x; a1[4 * s4 + 1] += u1 * w.y; a1[4 * s4 + 2] += u1 * w.z; a1[4 * s4 + 3] += u1 * w.w; }
                            if (q & 1) asm volatile("" ::: "memory");
                        }
                    }
#pragma unroll
                    for (int r = 0; r < 2; ++r) {
                        float t8[8], t4[4], t2[2], t1;
#pragma unroll
                        for (int k = 0; k < 8; ++k) { const float lo = r ? a1[k] : a0[k], hi = r ? a1[k + 8] : a0[k + 8]; const float keep = b5 ? hi : lo, send = b5 ? lo : hi; t8[k] = keep + __shfl_xor(send, 32); }
#pragma unroll
                        for (int k = 0; k < 4; ++k) { const float keep = b4 ? t8[k + 4] : t8[k], send = b4 ? t8[k] : t8[k + 4]; t4[k] = keep + __shfl_xor(send, 16); }
#pragma unroll
                        for (int k = 0; k < 2; ++k) { const float keep = b3 ? t4[k + 2] : t4[k], send = b3 ? t4[k] : t4[k + 2]; t2[k] = keep + __shfl_xor(send, 8); }
                        { const float keep = b2 ? t2[1] : t2[0], send = b2 ? t2[0] : t2[1]; t1 = keep + __shfl_xor(send, 4); }
                        t1 += __shfl_xor(t1, 2); t1 += __shfl_xor(t1, 1);
                        th[r][h] = t1;
                    }
                }
                const float bias = F.b_router[eidx];
                lgt[0] = ((ln & 1) ? th[0][1] : th[0][0]) + bias; lgt[1] = ((ln & 1) ? th[1][1] : th[1][0]) + bias;
            }
            int sel_e = 0; float sel_p = 0.f;
#pragma unroll
            for (int r = 0; r < 2; ++r) {
                unsigned key = fkey(lgt[r], eidx);
                int ek[4]; float vk[4];
#pragma unroll
                for (int k = 0; k < 4; ++k) {
                    unsigned m = key;
#pragma unroll
                    for (int o = 1; o < 64; o <<= 1) { if (o == 2) continue; const unsigned t = (unsigned)__shfl_xor((int)m, o); m = t > m ? t : m; }
                    const unsigned bs = (unsigned)__builtin_amdgcn_readfirstlane((int)m);
                    ek[k] = 31 - (int)(bs & 31u);
                    vk[k] = __int_as_float(__builtin_amdgcn_readlane(__float_as_int(lgt[r]), ((ek[k] & 15) << 2) | (ek[k] >> 4)));
                    if (eidx == ek[k]) key = 0u;
                }
                float pk[4], dsum = 0.f;
#pragma unroll
                for (int k = 0; k < 4; ++k) { pk[k] = __expf(vk[k] - vk[0]); dsum += pk[k]; }
                const float dinv = 1.f / dsum;
                const int kk = ln & 3;
                const int e = kk == 0 ? ek[0] : (kk == 1 ? ek[1] : (kk == 2 ? ek[2] : ek[3])); const float p = (kk == 0 ? pk[0] : (kk == 1 ? pk[1] : (kk == 2 ? pk[2] : pk[3]))) * dinv;
                if ((ln >> 2) == r) { sel_e = e; sel_p = p; }
            }
            if (ln < 8) {
                const int r = ln >> 2, k = ln & 3;
                const int lp = __hip_atomic_fetch_add(lcnt + sel_e, 1, __ATOMIC_RELAXED, __HIP_MEMORY_SCOPE_WORKGROUP);
                rec[((rl + r) * 4 + k) * 3 + 0] = sel_e; rec[((rl + r) * 4 + k) * 3 + 1] = lp; rec[((rl + r) * 4 + k) * 3 + 2] = (int)__float_as_uint(sel_p);
            }
        }
        __syncthreads();
        { int t_ = F.tid; asm volatile("" : "+v"(t_));
          if (t_ < 32) gbase[t_] = (int)__hip_atomic_fetch_add((unsigned*)cnt + t_, (unsigned)lcnt[t_], __ATOMIC_RELAXED, __HIP_MEMORY_SCOPE_AGENT); }
        __syncthreads();
        if (F.tid < 256) { const int e = rec[F.tid * 3], lp = rec[F.tid * 3 + 1]; const int pos = gbase[e] + lp;
            list[(size_t)e * NTOK + pos] = (tile * 64 + (F.tid >> 2)) * 4 + (F.tid & 3); listw[(size_t)e * NTOK + pos] = __uint_as_float((unsigned)rec[F.tid * 3 + 2]); }
        __syncthreads();
    }
}
__device__ __forceinline__ pg8::MoeTabs moe_tabs(Frame& F, int& ntiles) {
    const int* cnt = (const int*)(F.ws + WS_CTL) + CW_CNT;
    LAS int* tile_e = (LAS int*)(F.lds + TAB_OFF + T_TILE_E); LAS int* tile0 = (LAS int*)(F.lds + TAB_OFF + T_TILE0); LAS int* lc = (LAS int*)(F.lds + TAB_OFF + T_CNT); LAS int* lnt = (LAS int*)(F.lds + TAB_OFF + T_NT);
    __syncthreads();
    if (F.tid == 0) { int nt = 0;
        for (int e = 0; e < NE; ++e) { const int c = cnt[e]; lc[e] = c; tile0[e] = nt; const int t = (c + 255) >> 8; for (int i = 0; i < t; ++i) tile_e[nt + i] = e; nt += t; }
        tile0[NE] = nt; lnt[0] = nt; }
    __syncthreads();
    ntiles = lnt[0];
    pg8::MoeTabs T; T.tile_e = tile_e; T.tile0 = tile0; T.cnt = lc; return T;
}
__device__ __forceinline__ void p10_final(Frame& F) {
    const float* ada = (const float*)(F.ws + WS_ADA); const bf16_t* YB = (const bf16_t*)(F.ws + WS_YB);
    const int gw = F.vcu * NWAVES + F.wave, NGW = F.G * NWAVES;
    f32x4 nx[4]; u32x2 ny[4][4];
    if (gw < NTOK) { const GAS f32x4* xr = (const GAS f32x4*)(F.out + (size_t)gw * D) + F.lane;
#pragma unroll
        for (int j = 0; j < 4; ++j) { nx[j] = xr[64 * j];
#pragma unroll
            for (int k = 0; k < 4; ++k) ny[j][k] = *((const GAS u32x2*)(YB + ((size_t)gw * 4 + k) * D) + F.lane + 64 * j); } }
    for (int row = gw; row < NTOK; row += NGW) {
        GAS f32x4* xr = (GAS f32x4*)(F.out + (size_t)row * D) + F.lane;
        const f32x4* gate = (const f32x4*)(ada + (row / S) * 6 * D + 5 * D) + F.lane;
        f32x4 v[4]; float s = 0.f;
#pragma unroll
        for (int j = 0; j < 4; ++j) {
            f32x4 f = {0.f, 0.f, 0.f, 0.f};
#pragma unroll
            for (int k = 0; k < 4; ++k) { const u32x2 y = ny[j][k]; f.x += bflo(y.x); f.y += bfhi(y.x); f.z += bflo(y.y); f.w += bfhi(y.y); }
            v[j] = nx[j] * DN_ALPHA + (gate[64 * j] + 1.0f) * f; s += (v[j].x + v[j].y) + (v[j].z + v[j].w);
        }
        if (row + NGW < NTOK) { const GAS f32x4* xn = (const GAS f32x4*)(F.out + (size_t)(row + NGW) * D) + F.lane;
#pragma unroll
            for (int j = 0; j < 4; ++j) { nx[j] = xn[64 * j];
#pragma unroll
                for (int k = 0; k < 4; ++k) ny[j][k] = *((const GAS u32x2*)(YB + ((size_t)(row + NGW) * 4 + k) * D) + F.lane + 64 * j); } }
        const float mean = wsum(s) * (1.f / D); float s2 = 0.f;
#pragma unroll
        for (int j = 0; j < 4; ++j) { v[j] = v[j] - mean; s2 += (v[j].x * v[j].x + v[j].y * v[j].y) + (v[j].z * v[j].z + v[j].w * v[j].w); }
        const float rstd = rsqrtf(wsum(s2) * (1.f / D) + LN_EPS);
#pragma unroll
        for (int j = 0; j < 4; ++j) xr[64 * j] = v[j] * rstd * ((const f32x4*)F.ln2_g)[F.lane + 64 * j] + ((const f32x4*)F.ln2_b)[F.lane + 64 * j];
    }
}

constexpr int NPHASES = 11;
constexpr int CW_BAR = 4096;
__global__ void __launch_bounds__(NWAVES * 64, 2) mk_fwd(Args args) {
    extern __shared__ __attribute__((aligned(16))) unsigned char lds_raw[];
    Frame F;
    F.lds = (LAS unsigned char*)lds_raw;
    F.tid = threadIdx.x; F.lane = F.tid & 63; F.wave = __builtin_amdgcn_readfirstlane(F.tid >> 6);
    F.G = gridDim.x; { const int bx = blockIdx.x; F.vcu = (F.G % 8 == 0) ? (bx % 8) * (F.G / 8) + bx / 8 : bx; }
    F.x = (const float*)args.in[0]; F.c = (const float*)args.in[1]; F.positions = (const int*)args.in[2]; F.w_ada = (const float*)args.in[3]; F.b_ada = (const float*)args.in[4];
    F.w_in = (const float*)args.in[5]; F.pool_w = (const float*)args.in[6]; F.pool_scale = (const float*)args.in[7]; F.w_pool_out = (const float*)args.in[8]; F.w_attn_out = (const float*)args.in[9];
    F.w_o = (const float*)args.in[10]; F.ln1_g = (const float*)args.in[11]; F.ln1_b = (const float*)args.in[12]; F.w_router = (const float*)args.in[13]; F.b_router = (const float*)args.in[14];
    F.w_gate = (const float*)args.in[15]; F.b_gate = (const float*)args.in[16]; F.w_up = (const float*)args.in[17]; F.b_up = (const float*)args.in[18]; F.w_down = (const float*)args.in[19];
    F.b_down = (const float*)args.in[20]; F.ln2_g = (const float*)args.in[21]; F.ln2_b = (const float*)args.in[22];
    F.out = args.out; F.ws = args.ws;
    unsigned char* ws = args.ws;
    volatile LAS unsigned* MISC = (volatile LAS unsigned*)(F.lds + TAB_OFF + T_MISC);
    if (F.tid < 32) MISC[F.tid] = 0u;
    __syncthreads();
    const int lo = args.ph_lo, hi = args.ph_hi;
    XcdBarrier bar; bar.bar = (unsigned*)(ws + WS_CTL) + CW_BAR; bar.x = 0; bar.st = nullptr;
    if (hi - lo > 1) bar = xcd_barrier_post((unsigned*)(ws + WS_CTL) + CW_BAR, MISC + 8);
#ifndef PH_EN
#define PH_EN 0x7ff
#endif
#define IN(k) (((PH_EN >> (k)) & 1) && lo <= (k) && (k) < hi)
#define BOTH(k) (IN(k) && IN((k) + 1))
#define GRID_BAR(k) do { if (BOTH(k)) xcd_barrier(bar); } while (0)
    bf16_t *U = (bf16_t*)(ws + WS_U), *ACAT = (bf16_t*)(ws + WS_ACAT), *H = (bf16_t*)(ws + WS_H), *YB = (bf16_t*)(ws + WS_YB); const bf16_t* U8 = (const bf16_t*)(ws + WS_U8);

    if (IN(0)) { asm volatile("; PHASE_MARK 0" ::: "memory"); p0_prologue(F); GRID_BAR(0); }
    if (IN(1)) { asm volatile("; PHASE_MARK 1" ::: "memory"); p1_lnmod(F); GRID_BAR(1); }
    if (IN(2)) { asm volatile("; PHASE_MARK 2" ::: "memory");
        pg8::ProbDense<1024> P{U, (const bf16_t*)(ws + WS_WIN)}; pg8::StaticOrder S_; S_.init(NTOK, INW, F.G, (int)blockIdx.x);
        pg8::EpiProj E{(bf16_t*)(ws + WS_XP), (bf16_t*)(ws + WS_Q), (bf16_t*)(ws + WS_K), (bf16_t*)(ws + WS_V), (bf16_t*)(ws + WS_GP), (bf16_t*)(ws + WS_GA), (const float*)(ws + WS_ROPE)};
        pg8::gemm_phase<pg8::ProbDense<1024>, pg8::EpiProj, pg8::StaticOrder, true>(F.lds, P, S_, E);
        GRID_BAR(2);
    }
    if (IN(3)) { asm volatile("; PHASE_MARK 3" ::: "memory"); p3_attention(F); p3_pool(F); GRID_BAR(3); }
    if (IN(4)) { asm volatile("; PHASE_MARK 4" ::: "memory"); p4_merge(F); GRID_BAR(4); }
    if (IN(5)) { asm volatile("; PHASE_MARK 5" ::: "memory");
        pg8::ProbDense<768> P{ACAT, (const bf16_t*)(ws + WS_WCAT)}; pg8::StaticOrder S_; S_.init(NTOK, D, F.G, (int)blockIdx.x);
        pg8::EpiMerged E{(const bf16_t*)(ws + WS_GP), (const bf16_t*)(ws + WS_GA), U};
        pg8::gemm_phase<pg8::ProbDense<768>, pg8::EpiMerged, pg8::StaticOrder, false>(F.lds, P, S_, E);
        GRID_BAR(5);
    }
    if (IN(6)) { asm volatile("; PHASE_MARK 6" ::: "memory");
        pg8::ProbDense<1024> P{U, (const bf16_t*)(ws + WS_WO)}; pg8::StaticOrder S_; S_.init(NTOK, D, F.G, (int)blockIdx.x);
        pg8::EpiWo E{F.x, (const float*)(ws + WS_ADA), F.out};
        pg8::gemm_phase<pg8::ProbDense<1024>, pg8::EpiWo, pg8::StaticOrder, false>(F.lds, P, S_, E);
        GRID_BAR(6);
    }
    if (IN(7)) { asm volatile("; PHASE_MARK 7" ::: "memory"); p7_router(F); GRID_BAR(7); }
    if (IN(8)) { asm volatile("; PHASE_MARK 8" ::: "memory");
        int ntiles; const pg8::MoeTabs T = moe_tabs(F, ntiles);
        pg8::ProbGU P{U8, (const bf16_t*)(ws + WS_WGU), (const int*)(ws + WS_LIST), T}; pg8::MoeOrder S_; S_.init(ntiles, 8, F.G, (int)blockIdx.x);
        pg8::EpiGU E{F.b_gate, F.b_up, H, T};
        pg8::gemm_phase<pg8::ProbGU, pg8::EpiGU, pg8::MoeOrder, true, true>(F.lds, P, S_, E);
        GRID_BAR(8);
    }
    if (IN(9)) { asm volatile("; PHASE_MARK 9" ::: "memory");
        int ntiles; const pg8::MoeTabs T = moe_tabs(F, ntiles);
        pg8::ProbDown P{H, (const bf16_t*)(ws + WS_WDN), T}; pg8::MoeOrder S_; S_.init(ntiles, 4, F.G, (int)blockIdx.x);
        pg8::EpiDown E{F.b_down, (const float*)(ws + WS_LISTW), (const int*)(ws + WS_LIST), YB, T};
        pg8::gemm_phase<pg8::ProbDown, pg8::EpiDown, pg8::MoeOrder, true, true>(F.lds, P, S_, E);
        GRID_BAR(9);
    }
    if (IN(10)) { asm volatile("; PHASE_MARK 10" ::: "memory"); p10_final(F); }
#undef IN
#undef BOTH
#undef GRID_BAR
}


#ifndef MK_SPLIT
#define MK_SPLIT 0
#endif
extern "C" void kernel_launch(void* const* d_in, const int* in_sizes, int n_in, void* d_out, int out_size, void* d_ws, size_t ws_size, hipStream_t stream) {
    if (ws_size < WS_END || n_in < 23) { fprintf(stderr, "kernel_launch: workspace too small or wrong input count\n"); return; }
    static int grid = 0;
    if (grid == 0) {
        int dev = 0, cus = 0;
        if (hipGetDevice(&dev) != hipSuccess || hipDeviceGetAttribute(&cus, hipDeviceAttributeMultiprocessorCount, dev) != hipSuccess) { grid = -1; return; }
        if (hipFuncSetAttribute((const void*)mk_fwd, hipFuncAttributeMaxDynamicSharedMemorySize, LDS_BYTES) != hipSuccess) { fprintf(stderr, "kernel_launch: hipFuncSetAttribute failed\n"); grid = -1; return; }
        int per_cu = 0;
        if (hipOccupancyMaxActiveBlocksPerMultiprocessor(&per_cu, (const void*)mk_fwd, NWAVES * 64, LDS_BYTES) != hipSuccess || per_cu < 1) fprintf(stderr, "kernel_launch: occupancy query says %d\n", per_cu);
        (void)hipGetLastError();
        grid = cus;
    }
    if (grid < 0) return;
    unsigned char* ws = (unsigned char*)d_ws;
    (void)hipMemsetAsync(ws + WS_CTL, 0, CTL_BYTES, stream);
    Args a{};
    for (int i = 0; i < 23; ++i) a.in[i] = d_in[i];
    a.out = (float*)d_out; a.ws = ws;
    if (!MK_SPLIT) { a.ph_lo = 0; a.ph_hi = NPHASES; hipLaunchKernelGGL(mk_fwd, dim3(grid), dim3(NWAVES * 64), LDS_BYTES, stream, a); return; }
    for (int ph = 0; ph < NPHASES; ++ph) { a.ph_lo = ph; a.ph_hi = ph + 1; hipLaunchKernelGGL(mk_fwd, dim3(grid), dim3(NWAVES * 64), LDS_BYTES, stream, a); }
}
```
